# Optimizing an MI355X kernel written in HIP

```python
import math
import jax, jax.numpy as jnp
from jax import lax
import numpy as np

D_MODEL = 1024
BATCH = 8
SEQ = 4096
DEPTH = 2

D_G = D_MODEL // 4
N_GROUPS = 5
D_MIX = N_GROUPS * D_G
N_SUB = 4
HEAD_DIM = D_G // N_SUB
CONV_A = 3
CONV_D = 31
CHUNK = 128
POOL_WINDOWS = (2, 4, 8, 16)
MEM_LEN = 256
LN_EPS = 1e-5
DEEPNORM_ALPHA = (2.0 * DEPTH) ** 0.25
DEEPNORM_BETA = (8.0 * DEPTH) ** -0.25

SPLIT_SIZES = (D_G, D_G, D_G, D_G, D_G, D_G, D_G, D_G, D_G, D_MIX)
D_IN = sum(SPLIT_SIZES)
SPLIT_OFFSETS = tuple(int(o) for o in np.cumsum(SPLIT_SIZES)[:-1])

kernel_name = "hybrid_parallel_conv_sgu_pool_conformer_memxattn"


def layer_norm(x, g, b):
    xf = x.astype(jnp.float32)
    mu = jnp.mean(xf, axis=-1, keepdims=True)
    var = jnp.mean(jnp.square(xf - mu), axis=-1, keepdims=True)
    y = (xf - mu) * lax.rsqrt(var + LN_EPS) * g.astype(jnp.float32) + b.astype(jnp.float32)
    return y.astype(x.dtype)


def causal_depthwise_conv(x, w):
    k, c = w.shape
    return lax.conv_general_dilated(
        x, w[:, None, :].astype(x.dtype), window_strides=(1,), padding=[(k - 1, 0)],
        dimension_numbers=("NWC", "WIO", "NWC"), feature_group_count=c)


def short_gated_conv(xa, ba, ca, w_conv):
    return ba * causal_depthwise_conv(ca * xa, w_conv)


def spatial_gating(u, v, ln_g, ln_b, w_s, b_s):
    bn, s, _ = v.shape
    u = jax.nn.gelu(u)
    v = layer_norm(jax.nn.gelu(v), ln_g, ln_b)
    v = v.reshape(bn, s // CHUNK, CHUNK, N_SUB, HEAD_DIM)
    mask = jnp.tril(jnp.ones((CHUNK, CHUNK), dtype=bool))
    w = jnp.where(mask[None], w_s, jnp.zeros_like(w_s))
    mixed = jnp.einsum("hts,bcshd->bcthd", w, v) + b_s.T[:, :, None]
    return u * mixed.reshape(bn, s, D_G)


def multiscale_pool(xc, w_grp, scale):
    bn, s, _ = xc.shape
    xf = xc.astype(jnp.float32).reshape(bn, s, N_SUB, HEAD_DIM)
    cs = jnp.pad(jnp.cumsum(xf, axis=1), ((0, 0), (1, 0), (0, 0), (0, 0)))
    t = jnp.arange(s)
    win = jnp.array(POOL_WINDOWS, dtype=jnp.int32)
    lo = jnp.maximum(t[:, None] + 1 - win[None, :], 0)
    window_sum = cs[:, 1:] - cs[:, lo, jnp.arange(N_SUB)[None, :]]
    count = jnp.minimum(t[:, None] + 1, win[None, :]).astype(jnp.float32)
    y = (window_sum / count[None, :, :, None] - xf).astype(xc.dtype)
    y = jnp.einsum("bsgc,gcd->bsgd", y, w_grp)
    return y.reshape(bn, s, D_G) * scale


def conformer_conv(a, g, w_dw, b_dw, ln_g, ln_b, w_pw):
    h = a * jax.nn.sigmoid(g)
    h = causal_depthwise_conv(h, w_dw) + b_dw
    h = jax.nn.silu(layer_norm(h, ln_g, ln_b))
    return h @ w_pw


def memory_cross_attention(q, mem, w_kv):
    bn, s, _ = q.shape
    k, v = jnp.split(mem @ w_kv, 2, axis=-1)
    q = q.reshape(bn, s, N_SUB, HEAD_DIM)
    k = k.reshape(bn, -1, N_SUB, HEAD_DIM)
    v = v.reshape(bn, -1, N_SUB, HEAD_DIM)
    scores = jnp.einsum("bshd,bmhd->bhsm", q, k).astype(jnp.float32) * (1.0 / math.sqrt(HEAD_DIM))
    p = jax.nn.softmax(scores, axis=-1).astype(v.dtype)
    return jnp.einsum("bhsm,bmhd->bshd", p, v).reshape(bn, s, D_G)


def hybrid_mixer(x, mem, w_in, conv_a_w, sg_ln_g, sg_ln_b, sg_w, sg_b, pool_w, pool_scale,
                 cc_dw_w, cc_dw_b, cc_ln_g, cc_ln_b, cc_pw_w, w_kv, w_out):
    proj = x @ w_in
    xa, ba, ca, u, v, xc, da, dg, q, gate = jnp.split(proj, SPLIT_OFFSETS, axis=-1)
    y_a = short_gated_conv(xa, ba, ca, conv_a_w)
    y_b = spatial_gating(u, v, sg_ln_g, sg_ln_b, sg_w, sg_b)
    y_c = multiscale_pool(xc, pool_w, pool_scale)
    y_d = conformer_conv(da, dg, cc_dw_w, cc_dw_b, cc_ln_g, cc_ln_b, cc_pw_w)
    y_e = memory_cross_attention(q, mem, w_kv)
    h = jnp.concatenate([y_a, y_b, y_c, y_d, y_e], axis=-1) * jax.nn.silu(gate)
    return h @ w_out


def setup_inputs(seed: int = 0) -> dict:
    key = jax.random.key(seed)
    ks = jax.random.split(key, 20)
    L = DEPTH

    def nrm(k, shape, scale):
        return jax.random.normal(k, shape, jnp.float32) * scale

    return {
        "x": nrm(ks[0], (BATCH, SEQ, D_MODEL), 1.0),
        "mem": nrm(ks[1], (BATCH, MEM_LEN, D_MODEL), 1.0),
        "w_in": nrm(ks[2], (L, D_MODEL, D_IN), D_MODEL ** -0.5),
        "conv_a_w": nrm(ks[3], (L, CONV_A, D_G), CONV_A ** -0.5),
        "sg_ln_g": 1.0 + nrm(ks[4], (L, D_G), 0.05),
        "sg_ln_b": nrm(ks[5], (L, D_G), 0.05),
        "sg_w": nrm(ks[6], (L, N_SUB, CHUNK, CHUNK), CHUNK ** -0.5),
        "sg_b": 1.0 + nrm(ks[7], (L, N_SUB, CHUNK), 0.1),
        "pool_w": nrm(ks[8], (L, N_SUB, HEAD_DIM, HEAD_DIM), HEAD_DIM ** -0.5),
        "pool_scale": 1.0 + nrm(ks[9], (L, D_G), 0.1),
        "cc_dw_w": nrm(ks[10], (L, CONV_D, D_G), CONV_D ** -0.5),
        "cc_dw_b": nrm(ks[11], (L, D_G), 0.02),
        "cc_ln_g": 1.0 + nrm(ks[12], (L, D_G), 0.05),
        "cc_ln_b": nrm(ks[13], (L, D_G), 0.05),
        "cc_pw_w": nrm(ks[14], (L, D_G, D_G), D_G ** -0.5),
        "w_kv": nrm(ks[15], (L, D_MODEL, 2 * D_G), D_MODEL ** -0.5),
        "w_out": nrm(ks[16], (L, D_MIX, D_MODEL), D_MIX ** -0.5 * DEEPNORM_BETA),
        "ln_g": 1.0 + nrm(ks[17], (L, D_MODEL), 0.05),
        "ln_b": nrm(ks[18], (L, D_MODEL), 0.05),
    }


def reference(x, mem, w_in, conv_a_w, sg_ln_g, sg_ln_b, sg_w, sg_b, pool_w, pool_scale,
              cc_dw_w, cc_dw_b, cc_ln_g, cc_ln_b, cc_pw_w, w_kv, w_out, ln_g, ln_b):
    for l in range(DEPTH):
        y = hybrid_mixer(x, mem, w_in[l], conv_a_w[l], sg_ln_g[l], sg_ln_b[l], sg_w[l], sg_b[l],
                         pool_w[l], pool_scale[l], cc_dw_w[l], cc_dw_b[l], cc_ln_g[l], cc_ln_b[l],
                         cc_pw_w[l], w_kv[l], w_out[l])
        x = layer_norm(DEEPNORM_ALPHA * x + y, ln_g[l], ln_b[l])
    return x
```

```cpp
#include <hip/hip_runtime.h>
#include <cstdio>
#include <cstdint>

typedef unsigned short bf16_t;
constexpr int D_MODEL = 1024, BATCH = 8, SEQ = 4096, DEPTH = 2, D_G = 256, D_MIX = 1280, D_IN = 3584, MEM_LEN = 256;
constexpr int M = BATCH * SEQ;
constexpr int MM = BATCH * MEM_LEN;
constexpr float LN_EPS = 1e-5f;
constexpr float ALPHA = 1.41421356237309515f;
constexpr int C_XA = 0, C_BA = 256, C_CA = 512, C_U = 768, C_V = 1024, C_XC = 1280, C_DA = 1536, C_DG = 1792, C_Q = 2048, C_GATE = 2304;

__device__ __forceinline__ float bf2f(bf16_t v) { return __uint_as_float((unsigned)v << 16); }
__device__ __forceinline__ bf16_t f2bf(float f) { unsigned u = __float_as_uint(f); return (bf16_t)((u + 0x7fffu + ((u >> 16) & 1u)) >> 16); }
__device__ __forceinline__ float sigmoidf_(float x) { return 1.f / (1.f + __expf(-x)); }
__device__ __forceinline__ float siluf_(float x) { return x * sigmoidf_(x); }
__device__ __forceinline__ float geluf_(float x) { const float u = 0.7978845608028654f * (x + 0.044715f * x * x * x); return x * sigmoidf_(2.f * u); }
__device__ __forceinline__ float wave_sum(float v) {
#pragma unroll
    for (int o = 1; o < 64; o <<= 1) v += __shfl_xor(v, o);
    return v;
}

__global__ void k_cvt(const float* __restrict__ src, bf16_t* __restrict__ dst, size_t n) {
    for (size_t i = (size_t)blockIdx.x * blockDim.x + threadIdx.x; i < n; i += (size_t)gridDim.x * blockDim.x) dst[i] = f2bf(src[i]);
}
__global__ void k_cvt_t(const float* __restrict__ W, bf16_t* __restrict__ WT, int K, int N) {
    const size_t n_el = (size_t)K * N;
    for (size_t i = (size_t)blockIdx.x * blockDim.x + threadIdx.x; i < n_el; i += (size_t)gridDim.x * blockDim.x) {
        const int n = (int)(i / K), k = (int)(i % K);
        WT[i] = f2bf(W[(size_t)k * N + n]);
    }
}

struct EpiStoreBf16 { bf16_t* C; int ldc; __device__ void operator()(int r, int c, float v) const { C[(size_t)r * ldc + c] = f2bf(v); } };
struct EpiStoreF32 { float* C; int ldc; __device__ void operator()(int r, int c, float v) const { C[(size_t)r * ldc + c] = v; } };
struct EpiResid { float* Z; const float* xf; const bf16_t* xb; __device__ void operator()(int r, int c, float v) const {
    const size_t o = (size_t)r * D_MODEL + c; const float xr = xf ? xf[o] : bf2f(xb[o]); Z[o] = ALPHA * xr + v; } };

template <class Epi>
__global__ void __launch_bounds__(256) k_gemm_simple(const bf16_t* __restrict__ A, const bf16_t* __restrict__ Bt, int Mr, int N, int K, Epi epi) {
    __shared__ float sA[16][65], sB[16][65];
    const int bm = blockIdx.y * 64, bn = blockIdx.x * 64, tid = threadIdx.x, tx = tid & 15, ty = tid >> 4;
    float acc[4][4];
#pragma unroll
    for (int i = 0; i < 4; ++i)
#pragma unroll
        for (int j = 0; j < 4; ++j) acc[i][j] = 0.f;
    for (int k0 = 0; k0 < K; k0 += 16) {
#pragma unroll
        for (int i = 0; i < 4; ++i) { const int e = tid + i * 256, r = e >> 4, c = e & 15;
            sA[c][r] = bf2f(A[(size_t)(bm + r) * K + k0 + c]); sB[c][r] = bf2f(Bt[(size_t)(bn + r) * K + k0 + c]); }
        __syncthreads();
#pragma unroll
        for (int kk = 0; kk < 16; ++kk) {
            float a[4], b[4];
#pragma unroll
            for (int i = 0; i < 4; ++i) { a[i] = sA[kk][ty * 4 + i]; b[i] = sB[kk][tx * 4 + i]; }
#pragma unroll
            for (int i = 0; i < 4; ++i)
#pragma unroll
                for (int j = 0; j < 4; ++j) acc[i][j] += a[i] * b[j];
        }
        __syncthreads();
    }
#pragma unroll
    for (int i = 0; i < 4; ++i)
#pragma unroll
        for (int j = 0; j < 4; ++j) epi(bm + ty * 4 + i, bn + tx * 4 + j, acc[i][j]);
}

struct LayerW {
    const float *conv_a_w, *sg_ln_g, *sg_ln_b, *sg_w, *sg_b, *pool_w, *pool_scale, *cc_dw_w, *cc_dw_b, *cc_ln_g, *cc_ln_b, *cc_pw_w, *ln_g, *ln_b;
};
#define PJ(m, c) bf2f(proj[(size_t)(m) * D_IN + (c)])
#define GRID_STRIDE(i, n) for (size_t i = (size_t)blockIdx.x * blockDim.x + threadIdx.x; i < (size_t)(n); i += (size_t)gridDim.x * blockDim.x)

__global__ void k_branch_a(const bf16_t* __restrict__ proj, bf16_t* __restrict__ H, LayerW w) {
    GRID_STRIDE(i, (size_t)M * D_G) {
        const int m = (int)(i / D_G), c = (int)(i % D_G), t = m % SEQ;
        const float p0 = PJ(m, C_CA + c) * PJ(m, C_XA + c);
        const float p1 = t >= 1 ? PJ(m - 1, C_CA + c) * PJ(m - 1, C_XA + c) : 0.f;
        const float p2 = t >= 2 ? PJ(m - 2, C_CA + c) * PJ(m - 2, C_XA + c) : 0.f;
        const float cv = w.conv_a_w[0 * D_G + c] * p2 + w.conv_a_w[1 * D_G + c] * p1 + w.conv_a_w[2 * D_G + c] * p0;
        const float y = PJ(m, C_BA + c) * cv;
        H[(size_t)m * D_MIX + 0 + c] = f2bf(y * siluf_(PJ(m, C_GATE + 0 + c)));
    }
}
__global__ void __launch_bounds__(256) k_row_ln256(const bf16_t* __restrict__ proj, const float* __restrict__ Tin, float* __restrict__ Tout, const float* __restrict__ g, const float* __restrict__ b, int mode) {
    const int lane = threadIdx.x & 63; const int row0 = blockIdx.x * 4 + (threadIdx.x >> 6);
    for (int m = row0; m < M; m += gridDim.x * 4) {
        float v[4]; float s = 0.f;
#pragma unroll
        for (int j = 0; j < 4; ++j) { const int c = lane + 64 * j; v[j] = mode == 0 ? geluf_(PJ(m, C_V + c)) : Tin[(size_t)m * D_G + c]; s += v[j]; }
        const float mean = wave_sum(s) * (1.f / D_G); float q = 0.f;
#pragma unroll
        for (int j = 0; j < 4; ++j) { v[j] -= mean; q += v[j] * v[j]; }
        const float rstd = rsqrtf(wave_sum(q) * (1.f / D_G) + LN_EPS);
#pragma unroll
        for (int j = 0; j < 4; ++j) { const int c = lane + 64 * j; float y = v[j] * rstd * g[c] + b[c]; if (mode == 1) y = siluf_(y); Tout[(size_t)m * D_G + c] = y; }
    }
}
__global__ void k_branch_b2(const bf16_t* __restrict__ proj, const float* __restrict__ T, bf16_t* __restrict__ H, LayerW w) {
    GRID_STRIDE(i, (size_t)M * D_G) {
        const int m = (int)(i / D_G), c = (int)(i % D_G), t = m % 128, mb = m - t, h = c / 64;
        const float* wr = w.sg_w + ((size_t)h * 128 + t) * 128;
        float acc = 0.f;
        for (int s = 0; s <= t; ++s) acc += wr[s] * T[(size_t)(mb + s) * D_G + c];
        acc += w.sg_b[h * 128 + t];
        const float y = geluf_(PJ(m, C_U + c)) * acc;
        H[(size_t)m * D_MIX + 256 + c] = f2bf(y * siluf_(PJ(m, C_GATE + 256 + c)));
    }
}
__global__ void k_branch_c1(const bf16_t* __restrict__ proj, float* __restrict__ T) {
    GRID_STRIDE(i, (size_t)M * D_G) {
        const int m = (int)(i / D_G), c = (int)(i % D_G), t = m % SEQ, g = c / 64, win = 2 << g;
        const int cnt = (t + 1) < win ? (t + 1) : win;
        float s = 0.f;
        for (int j = 0; j < cnt; ++j) s += PJ(m - j, C_XC + c);
        T[i] = s / (float)cnt - PJ(m, C_XC + c);
    }
}
__global__ void k_branch_c2(const bf16_t* __restrict__ proj, const float* __restrict__ T, bf16_t* __restrict__ H, LayerW w) {
    GRID_STRIDE(i, (size_t)M * D_G) {
        const int m = (int)(i / D_G), n = (int)(i % D_G), g = n / 64, d = n % 64;
        float acc = 0.f;
        for (int c = 0; c < 64; ++c) acc += T[(size_t)m * D_G + g * 64 + c] * w.pool_w[((size_t)g * 64 + c) * 64 + d];
        const float y = acc * w.pool_scale[n];
        H[(size_t)m * D_MIX + 512 + n] = f2bf(y * siluf_(PJ(m, C_GATE + 512 + n)));
    }
}
__global__ void k_branch_d1(const bf16_t* __restrict__ proj, float* __restrict__ T, LayerW w) {
    GRID_STRIDE(i, (size_t)M * D_G) {
        const int m = (int)(i / D_G), c = (int)(i % D_G), t = m % SEQ;
        float acc = w.cc_dw_b[c];
        for (int j = 0; j < 31; ++j) { const int tt = t - 30 + j; if (tt >= 0) { const int mm = m - 30 + j; acc += w.cc_dw_w[j * D_G + c] * (PJ(mm, C_DA + c) * sigmoidf_(PJ(mm, C_DG + c))); } }
        T[i] = acc;
    }
}
__global__ void k_branch_d3(const bf16_t* __restrict__ proj, const float* __restrict__ T, bf16_t* __restrict__ H, LayerW w) {
    GRID_STRIDE(i, (size_t)M * D_G) {
        const int m = (int)(i / D_G), n = (int)(i % D_G);
        float acc = 0.f;
        for (int k = 0; k < D_G; ++k) acc += T[(size_t)m * D_G + k] * w.cc_pw_w[(size_t)k * D_G + n];
        H[(size_t)m * D_MIX + 768 + n] = f2bf(acc * siluf_(PJ(m, C_GATE + 768 + n)));
    }
}
__global__ void __launch_bounds__(256) k_branch_e(const bf16_t* __restrict__ proj, const float* __restrict__ KV, bf16_t* __restrict__ H) {
    const int idx = blockIdx.x * blockDim.x + threadIdx.x;
    const int h = idx / M, m = idx % M, b = m / SEQ;
    if (h >= 4) return;
    float q[64], acc[64];
#pragma unroll
    for (int d = 0; d < 64; ++d) { q[d] = PJ(m, C_Q + h * 64 + d) * 0.125f; acc[d] = 0.f; }
    float mx = -1e30f, l = 0.f;
    for (int key = 0; key < MEM_LEN; ++key) {
        const float* kr = KV + (size_t)(b * MEM_LEN + key) * 512 + h * 64; const float* vr = kr + 256;
        float s = 0.f;
#pragma unroll
        for (int d = 0; d < 64; ++d) s += q[d] * kr[d];
        const float mn = fmaxf(mx, s), a = __expf(mx - mn), p = __expf(s - mn);
        l = l * a + p; mx = mn;
#pragma unroll
        for (int d = 0; d < 64; ++d) acc[d] = acc[d] * a + p * vr[d];
    }
    const float inv = 1.f / l;
#pragma unroll
    for (int d = 0; d < 64; ++d) H[(size_t)m * D_MIX + 1024 + h * 64 + d] = f2bf(acc[d] * inv * siluf_(PJ(m, C_GATE + 1024 + h * 64 + d)));
}
__global__ void __launch_bounds__(256) k_ln1024(const float* __restrict__ Z, bf16_t* __restrict__ xb, float* __restrict__ out, const float* __restrict__ g, const float* __restrict__ b) {
    const int lane = threadIdx.x & 63; const int row0 = blockIdx.x * 4 + (threadIdx.x >> 6);
    for (int m = row0; m < M; m += gridDim.x * 4) {
        float v[16]; float s = 0.f;
#pragma unroll
        for (int j = 0; j < 16; ++j) { v[j] = Z[(size_t)m * D_MODEL + lane + 64 * j]; s += v[j]; }
        const float mean = wave_sum(s) * (1.f / D_MODEL); float q = 0.f;
#pragma unroll
        for (int j = 0; j < 16; ++j) { v[j] -= mean; q += v[j] * v[j]; }
        const float rstd = rsqrtf(wave_sum(q) * (1.f / D_MODEL) + LN_EPS);
#pragma unroll
        for (int j = 0; j < 16; ++j) { const int c = lane + 64 * j; const float y = v[j] * rstd * g[c] + b[c];
            if (xb) xb[(size_t)m * D_MODEL + c] = f2bf(y); if (out) out[(size_t)m * D_MODEL + c] = y; }
    }
}

constexpr size_t MiB = 1u << 20;
constexpr size_t WS_XB = 2 * MiB;
constexpr size_t WS_PROJ = 66 * MiB;
constexpr size_t WS_H = 290 * MiB;
constexpr size_t WS_WIN = 370 * MiB;
constexpr size_t WS_WOUT = 384 * MiB;
constexpr size_t WS_WKV = 390 * MiB;
constexpr size_t WS_MEMB = 392 * MiB;
constexpr size_t WS_KV = 396 * MiB;
constexpr size_t WS_T1 = 404 * MiB;
constexpr size_t WS_T2 = 436 * MiB;
constexpr size_t WS_END = 468 * MiB;

extern "C" void kernel_launch(void* const* d_in, const int* in_sizes, int n_in, void* d_out, int out_size, void* d_ws, size_t ws_size, hipStream_t stream) {
    if (n_in != 19 || ws_size < WS_END) { fprintf(stderr, "kernel_launch: unexpected n_in %d / ws %zu\n", n_in, ws_size); return; }
    const float* x = (const float*)d_in[0]; const float* mem = (const float*)d_in[1]; const float* w_in = (const float*)d_in[2];
    const float* w_kv = (const float*)d_in[15]; const float* w_out = (const float*)d_in[16];
    unsigned char* ws = (unsigned char*)d_ws;
    bf16_t* XB = (bf16_t*)(ws + WS_XB); bf16_t* PROJ = (bf16_t*)(ws + WS_PROJ); float* Z = (float*)(ws + WS_PROJ); bf16_t* H = (bf16_t*)(ws + WS_H);
    bf16_t* WIN = (bf16_t*)(ws + WS_WIN); bf16_t* WOUT = (bf16_t*)(ws + WS_WOUT); bf16_t* WKV = (bf16_t*)(ws + WS_WKV); bf16_t* MEMB = (bf16_t*)(ws + WS_MEMB);
    float* KV = (float*)(ws + WS_KV); float* T1 = (float*)(ws + WS_T1); float* T2 = (float*)(ws + WS_T2);
    const int G = 2048, B = 256;
    k_cvt<<<G, B, 0, stream>>>(x, XB, (size_t)M * D_MODEL);
    k_cvt<<<G, B, 0, stream>>>(mem, MEMB, (size_t)MM * D_MODEL);
    for (int l = 0; l < DEPTH; ++l) {
        k_cvt_t<<<G, B, 0, stream>>>(w_in + (size_t)l * D_MODEL * D_IN, WIN + (size_t)l * D_IN * D_MODEL, D_MODEL, D_IN);
        k_cvt_t<<<G, B, 0, stream>>>(w_out + (size_t)l * D_MIX * D_MODEL, WOUT + (size_t)l * D_MODEL * D_MIX, D_MIX, D_MODEL);
        k_cvt_t<<<G, B, 0, stream>>>(w_kv + (size_t)l * D_MODEL * 512, WKV + (size_t)l * 512 * D_MODEL, D_MODEL, 512);
        k_gemm_simple<<<dim3(512 / 64, MM / 64), 256, 0, stream>>>(MEMB, WKV + (size_t)l * 512 * D_MODEL, MM, 512, D_MODEL, EpiStoreF32{KV + (size_t)l * MM * 512, 512});
    }
    for (int l = 0; l < DEPTH; ++l) {
        LayerW w;
        w.conv_a_w = (const float*)d_in[3] + (size_t)l * 3 * D_G; w.sg_ln_g = (const float*)d_in[4] + (size_t)l * D_G; w.sg_ln_b = (const float*)d_in[5] + (size_t)l * D_G;
        w.sg_w = (const float*)d_in[6] + (size_t)l * 4 * 128 * 128; w.sg_b = (const float*)d_in[7] + (size_t)l * 4 * 128; w.pool_w = (const float*)d_in[8] + (size_t)l * 4 * 64 * 64;
        w.pool_scale = (const float*)d_in[9] + (size_t)l * D_G; w.cc_dw_w = (const float*)d_in[10] + (size_t)l * 31 * D_G; w.cc_dw_b = (const float*)d_in[11] + (size_t)l * D_G;
        w.cc_ln_g = (const float*)d_in[12] + (size_t)l * D_G; w.cc_ln_b = (const float*)d_in[13] + (size_t)l * D_G; w.cc_pw_w = (const float*)d_in[14] + (size_t)l * D_G * D_G;
        w.ln_g = (const float*)d_in[17] + (size_t)l * D_MODEL; w.ln_b = (const float*)d_in[18] + (size_t)l * D_MODEL;
        k_gemm_simple<<<dim3(D_IN / 64, M / 64), 256, 0, stream>>>(XB, WIN + (size_t)l * D_IN * D_MODEL, M, D_IN, D_MODEL, EpiStoreBf16{PROJ, D_IN});
        k_branch_a<<<G * 2, B, 0, stream>>>(PROJ, H, w);
        k_row_ln256<<<G, B, 0, stream>>>(PROJ, nullptr, T1, w.sg_ln_g, w.sg_ln_b, 0);
        k_branch_b2<<<G * 2, B, 0, stream>>>(PROJ, T1, H, w);
        k_branch_c1<<<G * 2, B, 0, stream>>>(PROJ, T1);
        k_branch_c2<<<G * 2, B, 0, stream>>>(PROJ, T1, H, w);
        k_branch_d1<<<G * 2, B, 0, stream>>>(PROJ, T1, w);
        k_row_ln256<<<G, B, 0, stream>>>(PROJ, T1, T2, w.cc_ln_g, w.cc_ln_b, 1);
        k_branch_d3<<<G * 2, B, 0, stream>>>(PROJ, T2, H, w);
        k_branch_e<<<(4 * M) / 256, 256, 0, stream>>>(PROJ, KV + (size_t)l * MM * 512, H);
        k_gemm_simple<<<dim3(D_MODEL / 64, M / 64), 256, 0, stream>>>(H, WOUT + (size_t)l * D_MODEL * D_MIX, M, D_MODEL, D_MIX, EpiResid{Z, l == 0 ? x : nullptr, XB});
        k_ln1024<<<G, B, 0, stream>>>(Z, l + 1 < DEPTH ? XB : nullptr, l + 1 < DEPTH ? nullptr : (float*)d_out, w.ln_g, w.ln_b);
    }
}
```

```cpp
#include <hip/hip_runtime.h>
#include <cstdio>
#include <cstdint>
namespace pg8 {
#define PG8_LAS __attribute__((address_space(3)))
typedef unsigned short bf16_t;
typedef short bf16x8 __attribute__((ext_vector_type(8)));
typedef float f32x4 __attribute__((ext_vector_type(4)));
typedef unsigned u32x4 __attribute__((ext_vector_type(4)));
constexpr int BM = 256, BK = 64, HALF = 128, HTB = HALF * BK * 2  , STAGE_BYTES = 8 * HTB, NXCD = 8, WGM = 8;

__host__ __device__ __forceinline__ int lds_byte(int r, int c) { const int st = (r >> 4) * 2 + (c >> 5), rr = r & 15, cc = c & 31, ob = rr * 64 + cc * 2; return st * 1024 + (ob ^ (((ob >> 9) & 1) << 5)); }
__host__ __device__ __forceinline__ void stage_rc(int b, int& R, int& C) { const int st = b / 1024, sb = b % 1024, swz = sb ^ (((sb >> 9) & 1) << 5); R = (st >> 1) * 16 + swz / 64; C = (st & 1) * 32 + (swz % 64) / 2; }
__host__ __device__ __forceinline__ int perm32(int rho) { const int n = rho >> 4, i = rho & 15; return 8 * (i >> 2) + 4 * n + (i & 3); }

struct Unit { int pm, pn; };
struct Gemm { const bf16_t* A; const bf16_t* Bt; int M, N, K; };

struct StaticOrder {
    int nM, nN, nwg, G, c;
    __host__ __device__ void init(int M, int N, int G_, int c_) { nM = M / BM; nN = N / BM; nwg = nM * nN; G = G_; c = c_; }
    __host__ __device__ bool next(int i, Unit& u) const {
        const long L = (long)i * G + c; if (L >= nwg) return false;
        int wgid = (int)L; { const int q = nwg / NXCD, r = nwg % NXCD, xcd = wgid % NXCD, off = wgid / NXCD; wgid = (xcd < r ? xcd * (q + 1) : r * (q + 1) + (xcd - r) * q) + off; }
        const int nig = WGM * nN, gid = wgid / nig, fm = gid * WGM, gsz = (nM - fm) < WGM ? (nM - fm) : WGM;
        u.pm = fm + ((wgid % nig) % gsz); u.pn = (wgid % nig) / gsz; return true;
    }
    __device__ __forceinline__ void a_ready(const Unit&) const {}
    __device__ __forceinline__ void done(const Unit&) const {}
};

__device__ __forceinline__ unsigned cvt_pk_bf16(float lo, float hi) { unsigned r; asm volatile("v_cvt_pk_bf16_f32 %0, %1, %2" : "=v"(r) : "v"(lo), "v"(hi)); return r; }
typedef float f32x2 __attribute__((ext_vector_type(2)));
__device__ __forceinline__ f32x2 gelu_pk(f32x2 v) {
    const f32x2 av = __builtin_elementwise_abs(v), d = av * 0.2316418882f + 1.0f;
    f32x2 t; t.x = __builtin_amdgcn_rcpf(d.x); t.y = __builtin_amdgcn_rcpf(d.y);
    f32x2 q = t * 0.5307027145f + (-0.7265760135f); q = q * t + 0.7107068705f; q = q * t + (-0.142248368f); q = q * t + 0.127414796f; q = q * t;
    const f32x2 s = (v * v) * (-0.72134752044f);
    f32x2 e; e.x = __builtin_amdgcn_exp2f(s.x); e.y = __builtin_amdgcn_exp2f(s.y);
    const f32x2 m = v * (q * e), r = v - m;
    f32x2 o; o.x = v.x < 0.f ? m.x : r.x; o.y = v.y < 0.f ? m.y : r.y; return o;
}

template <int ACT  > struct EpiBf16 {
    static constexpr bool PERM = true, AFTER_DRAIN = false; static_assert(ACT == 0 || ACT == 1, "EpiBf16: ACT is 0 (none) or 1 (gelu_pk)");
    bf16_t* O; int ldc; const float* bias; int split_cols; size_t split_stride; float scale0;
    __device__ __forceinline__ void operator()(const f32x4 (&acc)[2][2][4][2], const Unit& u, int wr, int wc, int fr, int fq) const {
        const int row0 = u.pm * BM + wr * 64 + fr; int colt = u.pn * BM; bf16_t* base = O;
        float sc = 1.f; if (split_cols) { const int t = colt / split_cols; base += (size_t)t * split_stride; colt -= t * split_cols; if (t == 0) sc = scale0; }
        const int col0 = colt + wc * 32 + 8 * fq, bcol0 = u.pn * BM + wc * 32 + 8 * fq;
        f32x4 bv[2][2];
#pragma unroll
        for (int bj = 0; bj < 2; ++bj)
#pragma unroll
            for (int n = 0; n < 2; ++n) bv[bj][n] = bias ? *(const f32x4*)(bias + bcol0 + bj * HALF + 4 * n) : (f32x4){0.f, 0.f, 0.f, 0.f};
#pragma unroll
        for (int ai = 0; ai < 2; ++ai)
#pragma unroll
            for (int m = 0; m < 4; ++m) { bf16_t* rowp = base + (size_t)(row0 + ai * HALF + m * 16) * ldc + col0;
#pragma unroll
                for (int bj = 0; bj < 2; ++bj) { f32x4 v0 = acc[ai][bj][m][0] + bv[bj][0], v1 = acc[ai][bj][m][1] + bv[bj][1];
                    if (ACT == 1) { f32x2 a = gelu_pk((f32x2){v0[0], v0[1]}), b = gelu_pk((f32x2){v0[2], v0[3]}), c = gelu_pk((f32x2){v1[0], v1[1]}), d = gelu_pk((f32x2){v1[2], v1[3]});
                        v0 = (f32x4){a.x, a.y, b.x, b.y}; v1 = (f32x4){c.x, c.y, d.x, d.y}; }
                    v0 = v0 * sc; v1 = v1 * sc; u32x4 w; w.x = cvt_pk_bf16(v0[0], v0[1]); w.y = cvt_pk_bf16(v0[2], v0[3]); w.z = cvt_pk_bf16(v1[0], v1[1]); w.w = cvt_pk_bf16(v1[2], v1[3]);
                    *(u32x4*)(rowp + bj * HALF) = w; } }
    }
};
template <class Epi, class Sched, bool ALIGN_EPI = false, bool SP2 = false>
__device__ __forceinline__ void gemm_phase(PG8_LAS unsigned char* lds, const Gemm g, const Sched& S, const Epi& E) {
    const int tid = threadIdx.x, wid = __builtin_amdgcn_readfirstlane(tid >> 6), lane = tid & 63, wr = wid >> 2, wc = wid & 3, fr = lane & 15, fq = lane >> 4;
    const int K = g.K, nt = K / BK;
    unsigned voffA[2], voffB[2];
#pragma unroll
    for (int i = 0; i < 2; ++i) { int R, C; stage_rc(tid * 16 + i * 8192, R, C); const int Rb = Epi::PERM ? ((R & ~31) + perm32(R & 31)) : R;
        voffA[i] = (unsigned)(R * K + C) * 2u; voffB[i] = (unsigned)(Rb * K + C) * 2u; }
    const size_t kstep = (size_t)(BK * 2);
    const size_t hstep = (size_t)HALF * K * 2;
    const size_t tstep = 2 * hstep;
    const unsigned ldsw = (unsigned)wid * 1024u;
    const int aoff = lds_byte(wr * 64 + fr, fq * 8), boff = lds_byte(wc * 32 + fr, fq * 8);
#define PG8_SA(b, h) (((b) * 2 + (h)) * HTB)
#define PG8_SB(b, h) ((4 + (b) * 2 + (h)) * HTB)
#define PG8_STAGE(bufoff, gbase, voff) do { _Pragma("unroll") for (int _i = 0; _i < 2; ++_i) \
        __builtin_amdgcn_global_load_lds((const unsigned*)((const char*)(gbase) + (voff)[_i]), (PG8_LAS unsigned*)(lds + (bufoff) + ldsw + _i * 8192), 16, 0, 0); } while (0)
#define PG8_LDA(dst, b, h) do { _Pragma("unroll") for (int m = 0; m < 4; ++m) _Pragma("unroll") for (int k = 0; k < 2; ++k) dst[m][k] = *(const PG8_LAS bf16x8*)(lds + PG8_SA(b, h) + aoff + m * 2048 + k * 1024); } while (0)
#define PG8_LDB(dst, b, h) do { _Pragma("unroll") for (int n = 0; n < 2; ++n) _Pragma("unroll") for (int k = 0; k < 2; ++k) dst[n][k] = *(const PG8_LAS bf16x8*)(lds + PG8_SB(b, h) + boff + n * 2048 + k * 1024); } while (0)
#define PG8_MMA(ai, bj, At, Bt) do { __builtin_amdgcn_s_setprio(1); _Pragma("unroll") for (int m = 0; m < 4; ++m) _Pragma("unroll") for (int n = 0; n < 2; ++n) _Pragma("unroll") for (int k = 0; k < 2; ++k) \
        acc[ai][bj][m][n] = __builtin_amdgcn_mfma_f32_16x16x32_bf16(Bt[n][k], At[m][k], acc[ai][bj][m][n], 0, 0, 0); __builtin_amdgcn_s_setprio(0); } while (0)
#define PG8_WAIT_V(n) asm volatile("s_waitcnt vmcnt(" #n ")" ::: "memory")
#define PG8_WAIT_L(n) asm volatile("s_waitcnt lgkmcnt(" #n ")" ::: "memory")
#define PG8_BAR __builtin_amdgcn_s_barrier()
#define PG8_SCHED __builtin_amdgcn_sched_barrier(0)
    Unit cur, nxt; int ui = 0;
    if (!S.next(0, cur)) return;
    f32x4 acc[2][2][4][2];
#pragma unroll
    for (int a = 0; a < 2; ++a)
#pragma unroll
        for (int b = 0; b < 2; ++b)
#pragma unroll
            for (int m = 0; m < 4; ++m)
#pragma unroll
                for (int n = 0; n < 2; ++n) acc[a][b][m][n] = (f32x4){0.f, 0.f, 0.f, 0.f};
    bf16x8 At[4][2], B0[2][2], B1[2][2];
    const char* cA = (const char*)g.A + (size_t)cur.pm * tstep; const char* cB = (const char*)g.Bt + (size_t)cur.pn * tstep;
    S.a_ready(cur);
    if constexpr (SP2) {
        PG8_STAGE(PG8_SB(0, 0), cB, voffB); PG8_STAGE(PG8_SB(0, 1), cB + hstep, voffB); PG8_STAGE(PG8_SA(0, 0), cA, voffA); PG8_STAGE(PG8_SA(0, 1), cA + hstep, voffA);
        if (wr == 1) PG8_BAR;
        PG8_WAIT_V(2); PG8_BAR;
        PG8_STAGE(PG8_SB(1, 0), cB + kstep, voffB); PG8_STAGE(PG8_SA(1, 0), cA + kstep, voffA); PG8_STAGE(PG8_SB(1, 1), cB + hstep + kstep, voffB);
        PG8_WAIT_V(6); PG8_BAR;
    } else {
        PG8_STAGE(PG8_SB(0, 0), cB, voffB); PG8_STAGE(PG8_SA(0, 0), cA, voffA); PG8_STAGE(PG8_SB(0, 1), cB + hstep, voffB); PG8_STAGE(PG8_SA(0, 1), cA + hstep, voffA);
        if (wr == 1) PG8_BAR;
        PG8_WAIT_V(4); PG8_BAR;
        PG8_STAGE(PG8_SB(1, 0), cB + kstep, voffB); PG8_STAGE(PG8_SA(1, 0), cA + kstep, voffA); PG8_STAGE(PG8_SB(1, 1), cB + hstep + kstep, voffB);
        PG8_WAIT_V(6); PG8_BAR;
    }
    for (;;) {
        const bool has_next = S.next(ui + 1, nxt);
        const char* nA = has_next ? (const char*)g.A + (size_t)nxt.pm * tstep : cA; const char* nB = has_next ? (const char*)g.Bt + (size_t)nxt.pn * tstep : cB;
        for (int t = 0; t < nt; t += 2) {
            const bool last = (t == nt - 2);
            const char* a1 = cA + (size_t)(t + 1) * kstep;
            const char* a2 = last ? nA : cA + (size_t)(t + 2) * kstep; const char* b2 = last ? nB : cB + (size_t)(t + 2) * kstep;
            const char* a3 = a2 + kstep; const char* b3 = b2 + kstep;
            if (last && has_next) S.a_ready(nxt);
            if constexpr (SP2) {
            PG8_LDB(B0, 0, 0); PG8_LDB(B1, 0, 1); PG8_SCHED; PG8_LDA(At, 0, 0); PG8_STAGE(PG8_SA(1, 1), a1 + hstep, voffA);
            PG8_WAIT_V(8); PG8_WAIT_L(0); PG8_BAR; PG8_MMA(0, 0, At, B0); PG8_MMA(0, 1, At, B1); PG8_BAR; PG8_SCHED;
            PG8_LDA(At, 0, 1); PG8_STAGE(PG8_SB(0, 0), b2, voffB); PG8_STAGE(PG8_SB(0, 1), b2 + hstep, voffB); PG8_STAGE(PG8_SA(0, 0), a2, voffA);
            PG8_WAIT_V(8); PG8_WAIT_L(0); PG8_BAR; PG8_MMA(1, 0, At, B0); PG8_MMA(1, 1, At, B1); PG8_BAR; PG8_SCHED;
            PG8_LDB(B0, 1, 0); PG8_LDB(B1, 1, 1); PG8_SCHED; PG8_LDA(At, 1, 0); PG8_STAGE(PG8_SA(0, 1), a2 + hstep, voffA);
            PG8_WAIT_V(8); PG8_WAIT_L(0); PG8_BAR; PG8_MMA(0, 0, At, B0); PG8_MMA(0, 1, At, B1); PG8_BAR; PG8_SCHED;
            PG8_LDA(At, 1, 1); PG8_STAGE(PG8_SB(1, 0), b3, voffB); PG8_STAGE(PG8_SB(1, 1), b3 + hstep, voffB); PG8_STAGE(PG8_SA(1, 0), a3, voffA);
            PG8_WAIT_V(8); PG8_WAIT_L(0); PG8_BAR; PG8_MMA(1, 0, At, B0); PG8_MMA(1, 1, At, B1); PG8_BAR; PG8_SCHED;
            } else {
            PG8_LDB(B0, 0, 0); PG8_SCHED; PG8_LDA(At, 0, 0); PG8_STAGE(PG8_SA(1, 1), a1 + hstep, voffA);
            PG8_WAIT_L(8); PG8_BAR; PG8_WAIT_L(0); PG8_MMA(0, 0, At, B0); PG8_BAR; PG8_SCHED;
            PG8_LDB(B1, 0, 1); PG8_STAGE(PG8_SB(0, 0), b2, voffB);
            PG8_BAR; PG8_WAIT_L(0); PG8_MMA(0, 1, At, B1); PG8_BAR;
            PG8_LDA(At, 0, 1); PG8_STAGE(PG8_SA(0, 0), a2, voffA);
            PG8_BAR; PG8_WAIT_L(0); PG8_MMA(1, 0, At, B0); PG8_BAR; PG8_SCHED;
            PG8_STAGE(PG8_SB(0, 1), b2 + hstep, voffB);
            PG8_WAIT_V(6); PG8_BAR; PG8_MMA(1, 1, At, B1); PG8_BAR;
            PG8_LDB(B0, 1, 0); PG8_SCHED; PG8_LDA(At, 1, 0); PG8_STAGE(PG8_SA(0, 1), a2 + hstep, voffA);
            PG8_WAIT_L(8); PG8_BAR; PG8_WAIT_L(0); PG8_MMA(0, 0, At, B0); PG8_BAR; PG8_SCHED;
            PG8_LDB(B1, 1, 1); PG8_STAGE(PG8_SB(1, 0), b3, voffB);
            PG8_BAR; PG8_WAIT_L(0); PG8_MMA(0, 1, At, B1); PG8_BAR;
            PG8_LDA(At, 1, 1); PG8_STAGE(PG8_SA(1, 0), a3, voffA);
            PG8_BAR; PG8_WAIT_L(0); PG8_MMA(1, 0, At, B0); PG8_BAR; PG8_SCHED;
            PG8_STAGE(PG8_SB(1, 1), b3 + hstep, voffB);
            PG8_WAIT_V(6); PG8_BAR; PG8_MMA(1, 1, At, B1); PG8_BAR;
            }
        }
        if constexpr (ALIGN_EPI) { if (wr == 0) PG8_BAR; }
        if constexpr (!Epi::AFTER_DRAIN) { E(acc, cur, wr, wc, fr, fq); S.done(cur); }
        if (!has_next) break;
#pragma unroll
        for (int a = 0; a < 2; ++a)
#pragma unroll
            for (int b = 0; b < 2; ++b)
#pragma unroll
                for (int m = 0; m < 4; ++m)
#pragma unroll
                    for (int n = 0; n < 2; ++n) acc[a][b][m][n] = (f32x4){0.f, 0.f, 0.f, 0.f};
        cur = nxt; cA = nA; cB = nB; ++ui;
        if constexpr (ALIGN_EPI) { if (wr == 1) PG8_BAR; }
    }
    PG8_WAIT_V(0);
    if constexpr (!ALIGN_EPI) { if (wr == 0) PG8_BAR; }
    PG8_BAR;
    if constexpr (Epi::AFTER_DRAIN) { E.fused(acc, cur, wr, wc, fr, fq, lds, wid, lane); S.done(cur); }
#undef PG8_SA
#undef PG8_SB
#undef PG8_STAGE
#undef PG8_LDA
#undef PG8_LDB
#undef PG8_MMA
#undef PG8_WAIT_V
#undef PG8_WAIT_L
#undef PG8_BAR
#undef PG8_SCHED
}
}
namespace pg8 {
__device__ __forceinline__ float bfu2f(unsigned short v) { return __uint_as_float((unsigned)v << 16); }
__device__ __forceinline__ unsigned short f2bfu(float f) { unsigned u = __float_as_uint(f); return (unsigned short)((u + 0x7fffu + ((u >> 16) & 1u)) >> 16); }
struct EpiKV {
    static constexpr bool PERM = false, AFTER_DRAIN = false;
    bf16_t* KB; bf16_t* VT;
    __device__ __forceinline__ void operator()(const f32x4 (&acc)[2][2][4][2], const Unit& u, int wr, int wc, int fr, int fq) const {
#pragma unroll
        for (int ai = 0; ai < 2; ++ai)
#pragma unroll
            for (int m = 0; m < 4; ++m) { const int row = u.pm * BM + ai * HALF + wr * 64 + m * 16 + fr;
#pragma unroll
                for (int bj = 0; bj < 2; ++bj)
#pragma unroll
                    for (int n = 0; n < 2; ++n) { const int c0 = bj * HALF + wc * 32 + n * 16 + 4 * fq; const f32x4 v = acc[ai][bj][m][n];
                        if (u.pn == 0) { const unsigned long long w = (unsigned long long)f2bfu(v[0]) | ((unsigned long long)f2bfu(v[1]) << 16) | ((unsigned long long)f2bfu(v[2]) << 32) | ((unsigned long long)f2bfu(v[3]) << 48);
                            *(unsigned long long*)(KB + (size_t)row * 256 + c0) = w; }
                        else { const int b = row >> 8, key = row & 255;
#pragma unroll
                            for (int i = 0; i < 4; ++i) VT[((size_t)(b * 256 + c0 + i)) * 256 + key] = f2bfu(v[i]); } } }
    }
};
struct EpiZ {
    static constexpr bool PERM = false, AFTER_DRAIN = false;
    float* Z; const float* xf; const bf16_t* xb; float alpha;
    __device__ __forceinline__ void operator()(const f32x4 (&acc)[2][2][4][2], const Unit& u, int wr, int wc, int fr, int fq) const {
        const int col0 = u.pn * BM + wc * 32 + 4 * fq;
#pragma unroll
        for (int ai = 0; ai < 2; ++ai)
#pragma unroll
            for (int m = 0; m < 4; ++m) { const size_t off = (size_t)(u.pm * BM + ai * HALF + wr * 64 + m * 16 + fr) * 1024 + col0;
#pragma unroll
                for (int bj = 0; bj < 2; ++bj)
#pragma unroll
                    for (int n = 0; n < 2; ++n) { const size_t o = off + bj * HALF + n * 16; f32x4 r;
                        if (xf) r = *(const f32x4*)(xf + o);
                        else { const unsigned long long w = *(const unsigned long long*)(xb + o); r = (f32x4){bfu2f((unsigned short)w), bfu2f((unsigned short)(w >> 16)), bfu2f((unsigned short)(w >> 32)), bfu2f((unsigned short)(w >> 48))}; }
                        *(f32x4*)(Z + o) = r * alpha + acc[ai][bj][m][n]; } }
    }
};
}
#ifndef PG8_SP2
#define PG8_SP2 true
#endif
#ifndef PG8_ALIGN
#define PG8_ALIGN true
#endif
#define GAS __attribute__((address_space(1)))
#define LAS __attribute__((address_space(3)))
typedef unsigned short bf16;
typedef unsigned v4u __attribute__((ext_vector_type(4)));
typedef float f32x4 __attribute__((ext_vector_type(4)));
typedef short bf16x8 __attribute__((ext_vector_type(8)));
typedef GAS unsigned gu32;
typedef GAS unsigned long long gu64;
#define RLX_AGENT __ATOMIC_RELAXED, __HIP_MEMORY_SCOPE_AGENT
#define LDS_WAIT() asm volatile("s_waitcnt lgkmcnt(0)" ::: "memory")
#define VM_WAIT() asm volatile("s_waitcnt vmcnt(0)" ::: "memory")
__device__ __forceinline__ unsigned long long rt() { return __builtin_amdgcn_s_memrealtime(); }
__device__ __forceinline__ unsigned f2bf(float f) { unsigned u = __builtin_bit_cast(unsigned, f); return (u + 0x7fffu + ((u >> 16) & 1u)) >> 16; }
__device__ __forceinline__ unsigned pk2(float lo, float hi) { return f2bf(lo) | (f2bf(hi) << 16); }

#define XB_TMO      128
#define XB_XCNT(j)  (256  + 64 * (j))
#define XB_XSUB(j)  (1280 + 64 * (j))
#define XB_XGEN(j)  (2304 + 64 * (j))
#define XB_TOP      3328
#define XB_TOPGEN   3392
#define XCD_BAR_WORDS 3456
#define XB_SPIN_CAP (1u << 18)

__device__ __forceinline__ unsigned xb_ld(unsigned* p)              { return __hip_atomic_load(p, __ATOMIC_RELAXED, __HIP_MEMORY_SCOPE_AGENT); }
__device__ __forceinline__ unsigned xb_add(unsigned* p, unsigned v) { return __hip_atomic_fetch_add(p, v, __ATOMIC_RELAXED, __HIP_MEMORY_SCOPE_AGENT); }
__device__ __forceinline__ unsigned xb_xcc_id() { return (unsigned)__builtin_amdgcn_s_getreg((3 << 11) | 20) & 0xFu; }
#define XB_SPIN(cond, bar) do { unsigned _sp = 0; while (cond) { __builtin_amdgcn_s_sleep(1); \
    if ((++_sp & 255u) == 0u) { if (xb_ld(&(bar)[XB_TMO])) break; if (_sp > XB_SPIN_CAP) { atomicAdd(&(bar)[XB_TMO], 1u); break; } } } } while (0)

struct XcdBarrier {
    unsigned* bar; unsigned x;
    volatile LAS unsigned* st;
};

__device__ __forceinline__ XcdBarrier xcd_barrier_post(unsigned* bar, volatile LAS unsigned* st) {
    XcdBarrier b; b.bar = bar; b.x = xb_xcc_id(); b.st = st;
    if (threadIdx.x == 0) (void)xb_add(&bar[XB_XCNT(b.x)], 1u);
    return b;
}
__device__ __forceinline__ void xcd_barrier_complete(unsigned* bar, unsigned x, unsigned& nloc, unsigned& nx) {
    const unsigned G = gridDim.x * gridDim.y * gridDim.z;
    unsigned sum, cnt, mine, sp = 0u;
    for (;;) {
        sum = 0u; cnt = 0u; mine = 0u;
#pragma unroll
        for (unsigned j = 0; j < 16; ++j) { const unsigned c = xb_ld(&bar[XB_XCNT(j)]); sum += c; cnt += (c > 0u) ? 1u : 0u; mine = (j == x) ? c : mine; }
        if (sum == G) break;
        __builtin_amdgcn_s_sleep(1);
        if ((++sp & 255u) == 0u) { if (xb_ld(&bar[XB_TMO])) break; if (sp > XB_SPIN_CAP) { atomicAdd(&bar[XB_TMO], 1u); break; } }
    }
    nloc = mine > 0u ? mine : 1u; nx = cnt > 0u ? cnt : 1u;
}

__device__ __forceinline__ void xcd_barrier(const XcdBarrier& b) {
    asm volatile("s_waitcnt vmcnt(0)" ::: "memory");
    __syncthreads();
    if (threadIdx.x == 0) {
        unsigned* bar = b.bar;
        __builtin_amdgcn_s_waitcnt(0);
        unsigned nloc = b.st[0], nx = b.st[1];
        if (nloc == 0u) { xcd_barrier_complete(bar, b.x, nloc, nx); b.st[0] = nloc; b.st[1] = nx; }
        const unsigned old = xb_add(&bar[XB_XSUB(b.x)], 1u);
        const unsigned gen = old / nloc;
        if (old + 1u == (gen + 1u) * nloc) {
            __builtin_amdgcn_fence(__ATOMIC_RELEASE, "agent");
            asm volatile("s_waitcnt vmcnt(0)" ::: "memory");
            const unsigned og = xb_add(&bar[XB_TOP], 1u);
            const unsigned tg = og / nx;
            if (og + 1u == (tg + 1u) * nx) xb_add(&bar[XB_TOPGEN], 1u);
            else XB_SPIN(xb_ld(&bar[XB_TOPGEN]) == tg, bar);
            __builtin_amdgcn_fence(__ATOMIC_ACQUIRE, "agent");
            xb_add(&bar[XB_XGEN(b.x)], 1u);
            asm volatile("s_waitcnt vmcnt(0)" ::: "memory");
        } else {
            XB_SPIN(xb_ld(&bar[XB_XGEN(b.x)]) == gen, bar);
            __builtin_amdgcn_fence(__ATOMIC_ACQUIRE, "agent");
            asm volatile("s_waitcnt vmcnt(0)" ::: "memory");
        }
    }
    __syncthreads();
}
typedef unsigned short bf16_t;
constexpr int NWAVES = 8;
constexpr int D_MODEL = 1024, BATCH = 8, SEQ = 4096, DEPTH = 2, D_G = 256, D_MIX = 1280, D_IN = 3584, MEM_LEN = 256;
constexpr int M = BATCH * SEQ;
constexpr int MM = BATCH * MEM_LEN;
constexpr float LN_EPS = 1e-5f;
constexpr float ALPHA = 1.41421356237309515f;
constexpr int C_XA = 0, C_BA = 256, C_CA = 512, C_U = 768, C_V = 1024, C_XC = 1280, C_DA = 1536, C_DG = 1792, C_Q = 2048, C_GATE = 2304;
constexpr int TILE = 128, NTILES = M / TILE;

constexpr size_t MiB = 1u << 20;
constexpr size_t WS_CTL = 0, CTL_ZERO_BYTES = 1 * MiB;
constexpr size_t WS_XB = 2 * MiB;
constexpr size_t WS_PROJ = 66 * MiB;
constexpr size_t WS_H = 290 * MiB;
constexpr size_t WS_WIN = 370 * MiB;
constexpr size_t WS_WOUT = 384 * MiB;
constexpr size_t WS_WKV = 390 * MiB;
constexpr size_t WS_MEMB = 392 * MiB;
constexpr size_t WS_KB = 396 * MiB;
constexpr size_t WS_VT = 398 * MiB;
constexpr size_t WS_PWT = 400 * MiB;
constexpr size_t WS_POOLT = 401 * MiB;
constexpr size_t WS_SGW = 402 * MiB;
constexpr size_t WS_T1 = 404 * MiB;
constexpr size_t WS_T2 = 436 * MiB;
constexpr size_t WS_END = 468 * MiB;
constexpr int CW_BAR = 4096;
constexpr int MAX_LAUNCHES = 9;
static_assert((CW_BAR + MAX_LAUNCHES * XCD_BAR_WORDS) * 4 <= (int)CTL_ZERO_BYTES, "CTL words inside the memset region");

constexpr int RING_OFF = 0, RING_BYTES = 131072;
constexpr int OUT_LD = 260;
constexpr int OUT_BYTES = TILE * OUT_LD * 4;
constexpr int VT_LD = 136;
constexpr int XC_BYTES = 143 * 512, A_OFF_C = 73728;
constexpr int A_LD = 264;
constexpr int A_BYTES = TILE * A_LD * 2;
constexpr int G_BYTES = 158 * 512, A_OFF_D = 81920;
constexpr int MIX_BYTES = A_OFF_D + A_BYTES;
constexpr int MISC_OFF = 150528;
constexpr int LDS_BYTES = 151552;
static_assert(XC_BYTES <= A_OFF_C && A_OFF_C + A_BYTES <= MIX_BYTES && G_BYTES <= A_OFF_D && OUT_BYTES <= MIX_BYTES && 256 * VT_LD * 2 <= MIX_BYTES && MIX_BYTES <= MISC_OFF && MISC_OFF + 128 <= LDS_BYTES, "LDS map");

typedef float f32x2 __attribute__((ext_vector_type(2)));
typedef float f32x16 __attribute__((ext_vector_type(16)));
typedef unsigned u32x2 __attribute__((ext_vector_type(2)));
#define DI __device__ __forceinline__
DI float bf2f(bf16_t v) { return __uint_as_float((unsigned)v << 16); }
DI float fast_sigmoid(float x) { return __builtin_amdgcn_rcpf(1.f + __builtin_amdgcn_exp2f(-1.44269504088896f * x)); }
DI float silu_f(float x) { return x * fast_sigmoid(x); }
DI float gelu_f(float x) { const float u = 1.5957691216057308f * (x + 0.044715f * x * x * x); return x * fast_sigmoid(u); }
DI unsigned cvtpk(float lo, float hi) { unsigned r; asm volatile("v_cvt_pk_bf16_f32 %0, %1, %2" : "=v"(r) : "v"(lo), "v"(hi)); return r; }
DI void unpack8(const v4u v, float (&f)[8]) {
    f[0] = __uint_as_float(v.x << 16); f[1] = __uint_as_float(v.x & 0xffff0000u); f[2] = __uint_as_float(v.y << 16); f[3] = __uint_as_float(v.y & 0xffff0000u);
    f[4] = __uint_as_float(v.z << 16); f[5] = __uint_as_float(v.z & 0xffff0000u); f[6] = __uint_as_float(v.w << 16); f[7] = __uint_as_float(v.w & 0xffff0000u);
}
DI v4u pack8(const float (&f)[8]) { v4u w; w.x = cvtpk(f[0], f[1]); w.y = cvtpk(f[2], f[3]); w.z = cvtpk(f[4], f[5]); w.w = cvtpk(f[6], f[7]); return w; }
DI float wave_sum(float v) {
#pragma unroll
    for (int o = 1; o < 64; o <<= 1) v += __shfl_xor(v, o);
    return v;
}
DI int crow(int reg, int h) { return (reg & 3) + 8 * (reg >> 2) + 4 * h; }
#define MFMA32(a, b, c) __builtin_amdgcn_mfma_f32_32x32x16_bf16((a), (b), (c), 0, 0, 0)
#define WG_BAR() __syncthreads()

struct LayerW {
    const float *conv_a_w, *sg_ln_g, *sg_ln_b, *sg_w, *sg_b, *pool_w, *pool_scale, *cc_dw_w, *cc_dw_b, *cc_ln_g, *cc_ln_b, *cc_pw_w, *ln_g, *ln_b;
    const bf16_t *KB, *VT, *PWT, *POOLT, *SGW;
};

DI void p0_transpose_item(const float* W, int K, int N, bf16_t* WT, LAS float* scr, int item, int lane) {
    const int nblk = N / 32, kb = item / nblk, nb = item % nblk, k0 = 64 * kb, n0 = 32 * nb;
#pragma unroll 8
    for (int i = 0; i < 32; ++i) { const int kk = 2 * i + (lane >> 5); scr[kk * 33 + (lane & 31)] = W[(size_t)(k0 + kk) * N + n0 + (lane & 31)]; }
    LDS_WAIT(); asm volatile("" ::: "memory");
    const int c = lane & 7;
#pragma unroll
    for (int j = 0; j < 4; ++j) { const int n = (lane >> 3) + 8 * j; const LAS float* s = scr + (8 * c) * 33 + n;
        v4u o; o.x = pk2(s[0 * 33], s[1 * 33]); o.y = pk2(s[2 * 33], s[3 * 33]); o.z = pk2(s[4 * 33], s[5 * 33]); o.w = pk2(s[6 * 33], s[7 * 33]);
        *(GAS v4u*)(WT + (size_t)(n0 + n) * K + k0 + 8 * c) = o; }
    LDS_WAIT(); asm volatile("" ::: "memory");
}
DI void cvt_row_1024(const float* src, bf16_t* dst, int lane) {
    const GAS f32x4* s = (const GAS f32x4*)src + lane; GAS u32x2* d = (GAS u32x2*)dst + lane;
    f32x4 v[4];
#pragma unroll
    for (int j = 0; j < 4; ++j) v[j] = s[64 * j];
#pragma unroll
    for (int j = 0; j < 4; ++j) { u32x2 o; o.x = pk2(v[j].x, v[j].y); o.y = pk2(v[j].z, v[j].w); d[64 * j] = o; }
}

struct Ptrs {
    const float* in[19]; float* out; unsigned char* ws;
};

DI void p0_prologue(const Ptrs& P, LAS unsigned char* lds, int vcu, int G, int wave, int lane) {
    LAS float* scr = (LAS float*)(lds + wave * 16384);
    const int gw = vcu * NWAVES + wave, NGW = G * NWAVES;
    unsigned char* ws = P.ws;
    constexpr int I_IN = (D_MODEL / 64) * (D_IN / 32), I_OUT = (D_MIX / 64) * (D_MODEL / 32), I_KV = (D_MODEL / 64) * (512 / 32), I_PW = (D_G / 64) * (D_G / 32), I_PL = 4 * 2;
    constexpr int I_LAYER = I_IN + I_OUT + I_KV + I_PW + I_PL;
    for (int it = gw; it < DEPTH * I_LAYER; it += NGW) {
        const int l = it / I_LAYER; int r = it % I_LAYER;
        if (r < I_IN) { p0_transpose_item(P.in[2] + (size_t)l * D_MODEL * D_IN, D_MODEL, D_IN, (bf16_t*)(ws + WS_WIN) + (size_t)l * D_IN * D_MODEL, scr, r, lane); continue; } r -= I_IN;
        if (r < I_OUT) { p0_transpose_item(P.in[16] + (size_t)l * D_MIX * D_MODEL, D_MIX, D_MODEL, (bf16_t*)(ws + WS_WOUT) + (size_t)l * D_MODEL * D_MIX, scr, r, lane); continue; } r -= I_OUT;
        if (r < I_KV) { p0_transpose_item(P.in[15] + (size_t)l * D_MODEL * 512, D_MODEL, 512, (bf16_t*)(ws + WS_WKV) + (size_t)l * 512 * D_MODEL, scr, r, lane); continue; } r -= I_KV;
        if (r < I_PW) { p0_transpose_item(P.in[14] + (size_t)l * D_G * D_G, D_G, D_G, (bf16_t*)(ws + WS_PWT) + (size_t)l * D_G * D_G, scr, r, lane); continue; } r -= I_PW;
        { const int g = r >> 1; p0_transpose_item(P.in[8] + ((size_t)l * 4 + g) * 64 * 64, 64, 64, (bf16_t*)(ws + WS_POOLT) + ((size_t)l * 4 + g) * 64 * 64, scr, r & 1, lane); }
    }
    for (int row = gw; row < DEPTH * 4 * 128; row += NGW) { const int t = row & 127; const float* s = P.in[6] + (size_t)row * 128; bf16_t* d = (bf16_t*)(ws + WS_SGW) + (size_t)row * 128;
        const int s0 = 2 * lane; const float a = s0 <= t ? s[s0] : 0.f, b = s0 + 1 <= t ? s[s0 + 1] : 0.f; *(GAS unsigned*)(d + s0) = pk2(a, b); }
    for (int m = gw; m < M; m += NGW) cvt_row_1024(P.in[0] + (size_t)m * D_MODEL, (bf16_t*)(ws + WS_XB) + (size_t)m * D_MODEL, lane);
    for (int m = gw; m < MM; m += NGW) cvt_row_1024(P.in[1] + (size_t)m * D_MODEL, (bf16_t*)(ws + WS_MEMB) + (size_t)m * D_MODEL, lane);
}

#ifndef MIX_A
#define MIX_A 1
#endif
#ifndef MIX_B
#define MIX_B 1
#endif
#ifndef MIX_C
#define MIX_C 1
#endif
#ifndef MIX_D
#define MIX_D 1
#endif
#ifndef MIX_E
#define MIX_E 1
#endif
template <int MODE>
DI void epi_pass(LAS unsigned char* lds, const bf16_t* proj, bf16_t* H, int m0, int goff, const float* scale, int tid) {
    const int cc = tid & 31, rg = tid >> 5;
    float sc[8];
    if (MODE == 2) { const f32x4 s0 = *(const f32x4*)(scale + 8 * cc), s1 = *(const f32x4*)(scale + 8 * cc + 4); sc[0] = s0.x; sc[1] = s0.y; sc[2] = s0.z; sc[3] = s0.w; sc[4] = s1.x; sc[5] = s1.y; sc[6] = s1.z; sc[7] = s1.w; }
#pragma unroll 2
    for (int i = 0; i < 8; ++i) {
        const int t = rg * 8 + i; const size_t m = (size_t)(m0 + t);
        const LAS float* op = (const LAS float*)(lds) + t * OUT_LD + 8 * cc;
        const f32x4 y0 = *(const LAS f32x4*)op, y1 = *(const LAS f32x4*)(op + 4);
        float y[8] = {y0.x, y0.y, y0.z, y0.w, y1.x, y1.y, y1.z, y1.w};
        float g[8]; unpack8(*(const v4u*)(proj + m * D_IN + C_GATE + goff + 8 * cc), g);
        if (MODE == 1) { float u[8]; unpack8(*(const v4u*)(proj + m * D_IN + C_U + 8 * cc), u);
#pragma unroll
            for (int j = 0; j < 8; ++j) y[j] *= gelu_f(u[j]); }
        if (MODE == 2) {
#pragma unroll
            for (int j = 0; j < 8; ++j) y[j] *= sc[j]; }
#pragma unroll
        for (int j = 0; j < 8; ++j) y[j] *= silu_f(g[j]);
        *(v4u*)(H + m * D_MIX + goff + 8 * cc) = pack8(y);
    }
}
DI void out_tile(LAS unsigned char* lds, const f32x16& acc, int trow0, int col, int hh) {
    LAS float* o = (LAS float*)lds + col;
#pragma unroll
    for (int r = 0; r < 16; ++r) o[(trow0 + crow(r, hh)) * OUT_LD] = acc[r];
}

template <int HALF_>
DI void conv_half(f32x2 (&cv)[16], const bf16_t* proj, const LayerW& W, LAS unsigned char* GL, int m0, int tseq0, int tid, int wave, int lane) {
    for (int ch = tid; ch < 158 * 16; ch += NWAVES * 64) { const int i = ch >> 4, c8 = ch & 15; float y[8];
#pragma unroll
        for (int j = 0; j < 8; ++j) y[j] = 0.f;
        if (tseq0 - 30 + i >= 0) { const bf16_t* pr = proj + (size_t)(m0 - 30 + i) * D_IN + HALF_ * 128 + 8 * c8; float a[8], gg[8]; unpack8(*(const v4u*)(pr + C_DA), a); unpack8(*(const v4u*)(pr + C_DG), gg);
#pragma unroll
            for (int j = 0; j < 8; ++j) y[j] = a[j] * fast_sigmoid(gg[j]); }
        LAS f32x4* d = (LAS f32x4*)(GL + i * 512 + c8 * 32); d[0] = (f32x4){y[0], y[1], y[2], y[3]}; d[1] = (f32x4){y[4], y[5], y[6], y[7]}; }
    WG_BAR();
    f32x2 wt[31];
    { const float* wp = W.cc_dw_w + HALF_ * 128 + 2 * lane;
#pragma unroll
      for (int j = 0; j < 31; ++j) { asm volatile("" : "+v"(wp)); wt[j] = *(const f32x2*)wp; wp += D_G; } }
    const f32x2 bias = *(const f32x2*)(W.cc_dw_b + HALF_ * 128 + 2 * lane);
#pragma unroll
    for (int o = 0; o < 16; ++o) cv[o] = bias;
    const LAS unsigned char* gp = GL + (16 * wave) * 512 + lane * 8;
#pragma unroll
    for (int r = 0; r < 46; ++r) { const f32x2 x = *(const LAS f32x2*)(gp + r * 512);
#pragma unroll
        for (int o = 0; o < 16; ++o) { const int j = r - o; if (j >= 0 && j <= 30) cv[o] += wt[j] * x; }
        if ((r & 3) == 3) asm volatile("" ::: "memory"); }
    WG_BAR();
}

DI void mixer_tile(const Ptrs& P, const LayerW& W, LAS unsigned char* lds, int tile, int tid, int wave, int lane) {
    const bf16_t* proj = (const bf16_t*)(P.ws + WS_PROJ); bf16_t* H = (bf16_t*)(P.ws + WS_H);
    const int m0 = tile * TILE, bidx = m0 / SEQ, tseq0 = m0 % SEQ;
    const int r32 = lane & 31, hh = lane >> 5;
    const int cc = tid & 31, rg = tid >> 5;
#if MIX_A
    {
        float w0[8], w1[8], w2[8];
        { const float* wc = W.conv_a_w + 8 * cc;
#pragma unroll
          for (int j = 0; j < 8; ++j) { w0[j] = wc[j]; w1[j] = wc[D_G + j]; w2[j] = wc[2 * D_G + j]; } }
        const int tb = rg * 8; float p1[8], p2[8];
#pragma unroll
        for (int j = 0; j < 8; ++j) { p1[j] = 0.f; p2[j] = 0.f; }
        if (tseq0 + tb - 2 >= 0) { float a[8], c[8]; const size_t m = (size_t)(m0 + tb - 2); unpack8(*(const v4u*)(proj + m * D_IN + C_XA + 8 * cc), a); unpack8(*(const v4u*)(proj + m * D_IN + C_CA + 8 * cc), c);
#pragma unroll
            for (int j = 0; j < 8; ++j) p2[j] = a[j] * c[j]; }
        if (tseq0 + tb - 1 >= 0) { float a[8], c[8]; const size_t m = (size_t)(m0 + tb - 1); unpack8(*(const v4u*)(proj + m * D_IN + C_XA + 8 * cc), a); unpack8(*(const v4u*)(proj + m * D_IN + C_CA + 8 * cc), c);
#pragma unroll
            for (int j = 0; j < 8; ++j) p1[j] = a[j] * c[j]; }
#pragma unroll 2
        for (int i = 0; i < 8; ++i) {
            const size_t m = (size_t)(m0 + tb + i); const bf16_t* pr = proj + m * D_IN + 8 * cc;
            float a[8], c[8], b[8], g[8], y[8];
            unpack8(*(const v4u*)(pr + C_XA), a); unpack8(*(const v4u*)(pr + C_CA), c); unpack8(*(const v4u*)(pr + C_BA), b); unpack8(*(const v4u*)(pr + C_GATE), g);
#pragma unroll
            for (int j = 0; j < 8; ++j) { const float p0 = a[j] * c[j]; const float cv = w0[j] * p2[j] + w1[j] * p1[j] + w2[j] * p0; y[j] = b[j] * cv * silu_f(g[j]); p2[j] = p1[j]; p1[j] = p0; }
            *(v4u*)(H + m * D_MIX + 0 + 8 * cc) = pack8(y);
        }
    }
#endif
#if MIX_B
    {
        LAS bf16_t* VTl = (LAS bf16_t*)lds;
        const f32x4 lg = *(const f32x4*)(W.sg_ln_g + 4 * lane), lb = *(const f32x4*)(W.sg_ln_b + 4 * lane);
#pragma unroll 4
        for (int i = 0; i < 16; ++i) {
            const int s = wave * 16 + i; const u32x2 raw = *(const u32x2*)(proj + (size_t)(m0 + s) * D_IN + C_V + 4 * lane);
            float v[4] = {__uint_as_float(raw.x << 16), __uint_as_float(raw.x & 0xffff0000u), __uint_as_float(raw.y << 16), __uint_as_float(raw.y & 0xffff0000u)};
#pragma unroll
            for (int j = 0; j < 4; ++j) v[j] = gelu_f(v[j]);
            const float mean = wave_sum((v[0] + v[1]) + (v[2] + v[3])) * (1.f / D_G);
#pragma unroll
            for (int j = 0; j < 4; ++j) v[j] -= mean;
            const float rstd = rsqrtf(wave_sum((v[0] * v[0] + v[1] * v[1]) + (v[2] * v[2] + v[3] * v[3])) * (1.f / D_G) + LN_EPS);
            const float y0 = v[0] * rstd * lg.x + lb.x, y1 = v[1] * rstd * lg.y + lb.y, y2 = v[2] * rstd * lg.z + lb.z, y3 = v[3] * rstd * lg.w + lb.w;
            const unsigned p01 = cvtpk(y0, y1), p23 = cvtpk(y2, y3);
            VTl[(4 * lane + 0) * VT_LD + s] = (bf16_t)p01; VTl[(4 * lane + 1) * VT_LD + s] = (bf16_t)(p01 >> 16);
            VTl[(4 * lane + 2) * VT_LD + s] = (bf16_t)p23; VTl[(4 * lane + 3) * VT_LD + s] = (bf16_t)(p23 >> 16);
        }
        WG_BAR();
        const int h = wave & 3, dh = wave >> 2;
        f32x16 acc[4];
#pragma unroll
        for (int tt = 0; tt < 4; ++tt)
#pragma unroll
            for (int r = 0; r < 16; ++r) acc[tt][r] = 0.f;
        const bf16_t* wg0 = W.SGW + ((size_t)h * 128 + r32) * 128 + hh * 8; const bf16_t *wg1 = wg0 + 32 * 128, *wg2 = wg0 + 64 * 128, *wg3 = wg0 + 96 * 128;
        asm volatile("" : "+v"(wg0), "+v"(wg1), "+v"(wg2), "+v"(wg3));
        const LAS bf16_t* vb = VTl + (h * 64 + dh * 32 + r32) * VT_LD + hh * 8;
#pragma unroll
        for (int ks = 0; ks < 8; ++ks) {
            const bf16x8 b = *(const LAS bf16x8*)(vb + ks * 16);
#pragma unroll
            for (int tt = 0; tt < 4; ++tt) if (ks <= 2 * tt + 1) { const bf16_t* wgt = tt == 0 ? wg0 : tt == 1 ? wg1 : tt == 2 ? wg2 : wg3; const bf16x8 a = *(const bf16x8*)(wgt + ks * 16); acc[tt] = MFMA32(a, b, acc[tt]); }
        }
        WG_BAR();
        { const float* sb = W.sg_b + h * 128;
#pragma unroll
          for (int tt = 0; tt < 4; ++tt) {
#pragma unroll
            for (int r = 0; r < 16; ++r) acc[tt][r] += sb[tt * 32 + crow(r, hh)];
            out_tile(lds, acc[tt], tt * 32, h * 64 + dh * 32 + r32, hh); } }
        WG_BAR();
        epi_pass<1>(lds, proj, H, m0, 256, nullptr, tid);
        WG_BAR();
    }
#endif
#if MIX_C
    {
        LAS unsigned char* XC = lds; LAS unsigned char* AT = lds + A_OFF_C;
        for (int ch = tid; ch < 143 * 32; ch += NWAVES * 64) { const int i = ch >> 5, c8 = ch & 31; v4u v = (v4u){0u, 0u, 0u, 0u};
            if (tseq0 - 15 + i >= 0) v = *(const v4u*)(proj + (size_t)(m0 - 15 + i) * D_IN + C_XC + 8 * c8);
            *(LAS v4u*)(XC + i * 512 + c8 * 16) = v; }
        WG_BAR();
        { const int g = cc >> 3, win = 2 << g, tb = rg * 8; float s[8];
#pragma unroll
          for (int j = 0; j < 8; ++j) s[j] = 0.f;
          for (int j = 1; j < win; ++j) { float x[8]; unpack8(*(const LAS v4u*)(XC + (tb + 15 - j) * 512 + cc * 16), x);
#pragma unroll
              for (int q = 0; q < 8; ++q) s[q] += x[q]; }
#pragma unroll 2
          for (int i = 0; i < 8; ++i) { const int t = tb + i; float x[8], y[8]; unpack8(*(const LAS v4u*)(XC + (t + 15) * 512 + cc * 16), x);
              const int av = tseq0 + t + 1; const float inv = 1.f / (float)(av < win ? av : win);
#pragma unroll
              for (int q = 0; q < 8; ++q) { s[q] += x[q]; y[q] = s[q] * inv - x[q]; }
              *(LAS v4u*)(AT + t * (A_LD * 2) + cc * 16) = pack8(y);
              float o[8]; unpack8(*(const LAS v4u*)(XC + (t + 16 - win) * 512 + cc * 16), o);
#pragma unroll
              for (int q = 0; q < 8; ++q) s[q] -= o[q]; } }
        WG_BAR();
        const int g = wave & 3, th = wave >> 2;
        f32x16 acc[2][2];
#pragma unroll
        for (int a = 0; a < 2; ++a)
#pragma unroll
            for (int b = 0; b < 2; ++b)
#pragma unroll
                for (int r = 0; r < 16; ++r) acc[a][b][r] = 0.f;
        const bf16_t* pl0 = W.POOLT + ((size_t)(g * 64 + r32)) * 64 + hh * 8; const bf16_t* pl1 = pl0 + 32 * 64;
        asm volatile("" : "+v"(pl0), "+v"(pl1));
#pragma unroll
        for (int ks = 0; ks < 4; ++ks) {
            bf16x8 af[2], bf[2];
#pragma unroll
            for (int tt = 0; tt < 2; ++tt) af[tt] = *(const LAS bf16x8*)(AT + (th * 64 + tt * 32 + r32) * (A_LD * 2) + (g * 64 + ks * 16 + hh * 8) * 2);
#pragma unroll
            for (int dt = 0; dt < 2; ++dt) bf[dt] = *(const bf16x8*)((dt ? pl1 : pl0) + ks * 16);
#pragma unroll
            for (int tt = 0; tt < 2; ++tt)
#pragma unroll
                for (int dt = 0; dt < 2; ++dt) acc[tt][dt] = MFMA32(af[tt], bf[dt], acc[tt][dt]);
        }
        WG_BAR();
#pragma unroll
        for (int tt = 0; tt < 2; ++tt)
#pragma unroll
            for (int dt = 0; dt < 2; ++dt) out_tile(lds, acc[tt][dt], th * 64 + tt * 32, g * 64 + dt * 32 + r32, hh);
        WG_BAR();
        epi_pass<2>(lds, proj, H, m0, 512, W.pool_scale, tid);
        WG_BAR();
    }
#endif
#if MIX_D
    {
        LAS unsigned char* GL = lds; LAS unsigned char* AT = lds + A_OFF_D;
        f32x2 cv0[16], cv1[16];
        conv_half<0>(cv0, proj, W, GL, m0, tseq0, tid, wave, lane);
        conv_half<1>(cv1, proj, W, GL, m0, tseq0, tid, wave, lane);
        { const f32x2 g0 = *(const f32x2*)(W.cc_ln_g + 2 * lane), g1 = *(const f32x2*)(W.cc_ln_g + 128 + 2 * lane), b0 = *(const f32x2*)(W.cc_ln_b + 2 * lane), b1 = *(const f32x2*)(W.cc_ln_b + 128 + 2 * lane);
#pragma unroll
          for (int o = 0; o < 16; ++o) {
            f32x2 x0 = cv0[o], x1 = cv1[o];
            const float mean = wave_sum((x0.x + x0.y) + (x1.x + x1.y)) * (1.f / D_G);
            x0 -= mean; x1 -= mean;
            const float rstd = rsqrtf(wave_sum((x0.x * x0.x + x0.y * x0.y) + (x1.x * x1.x + x1.y * x1.y)) * (1.f / D_G) + LN_EPS);
            const f32x2 y0 = x0 * rstd * g0 + b0, y1 = x1 * rstd * g1 + b1;
            LAS unsigned* ap = (LAS unsigned*)(AT + (16 * wave + o) * (A_LD * 2)) + lane;
            ap[0] = cvtpk(silu_f(y0.x), silu_f(y0.y)); ap[64] = cvtpk(silu_f(y1.x), silu_f(y1.y)); } }
        WG_BAR();
        f32x16 acc[4];
#pragma unroll
        for (int tt = 0; tt < 4; ++tt)
#pragma unroll
            for (int r = 0; r < 16; ++r) acc[tt][r] = 0.f;
        const bf16_t* bp = W.PWT + (size_t)(32 * wave + r32) * D_G + hh * 8;
        asm volatile("" : "+v"(bp));
#pragma unroll 4
        for (int ks = 0; ks < 16; ++ks) {
            const bf16x8 b = *(const bf16x8*)(bp + ks * 16);
#pragma unroll
            for (int tt = 0; tt < 4; ++tt) { const bf16x8 a = *(const LAS bf16x8*)(AT + (tt * 32 + r32) * (A_LD * 2) + (ks * 16 + hh * 8) * 2); acc[tt] = MFMA32(a, b, acc[tt]); }
        }
        WG_BAR();
#pragma unroll
        for (int tt = 0; tt < 4; ++tt) out_tile(lds, acc[tt], tt * 32, 32 * wave + r32, hh);
        WG_BAR();
        epi_pass<0>(lds, proj, H, m0, 768, nullptr, tid);
        WG_BAR();
    }
#endif
#if MIX_E
    {
        const bf16_t* KBb = W.KB + (size_t)bidx * MEM_LEN * 256; const bf16_t* VTb = W.VT + (size_t)bidx * 256 * 256;
#pragma unroll 1
        for (int job = wave; job < 16; job += NWAVES) {
            const int h = job & 3, tb = job >> 2;
            bf16x8 qf[4];
#pragma unroll
            for (int ks = 0; ks < 4; ++ks) qf[ks] = *(const bf16x8*)(proj + (size_t)(m0 + tb * 32 + r32) * D_IN + C_Q + h * 64 + ks * 16 + hh * 8);
            f32x16 st[8];
            const bf16_t* kp = KBb + (size_t)r32 * 256 + h * 64 + hh * 8;
            bf16x8 kf[4], kn[4];
            asm volatile("" : "+v"(kp));
#pragma unroll
            for (int ks = 0; ks < 4; ++ks) kf[ks] = *(const bf16x8*)(kp + ks * 16);
#pragma unroll
            for (int kt = 0; kt < 8; ++kt) {
                if (kt < 7) { kp += 32 * 256; asm volatile("" : "+v"(kp));
#pragma unroll
                    for (int ks = 0; ks < 4; ++ks) kn[ks] = *(const bf16x8*)(kp + ks * 16); }
#pragma unroll
                for (int r = 0; r < 16; ++r) st[kt][r] = 0.f;
#pragma unroll
                for (int ks = 0; ks < 4; ++ks) st[kt] = MFMA32(kf[ks], qf[ks], st[kt]);
#pragma unroll
                for (int ks = 0; ks < 4; ++ks) kf[ks] = kn[ks];
                asm volatile("" ::: "memory");
            }
            float mx = -1e30f;
#pragma unroll
            for (int kt = 0; kt < 8; ++kt)
#pragma unroll
                for (int r = 0; r < 16; ++r) mx = fmaxf(mx, st[kt][r]);
            mx = fmaxf(mx, __shfl_xor(mx, 32));
            float l = 0.f; const float c2 = 0.125f * 1.44269504088896f, mc = mx * c2;
#pragma unroll
            for (int kt = 0; kt < 8; ++kt)
#pragma unroll
                for (int r = 0; r < 16; ++r) { const float p = __builtin_amdgcn_exp2f(st[kt][r] * c2 - mc); st[kt][r] = p; l += p; }
            l += __shfl_xor(l, 32);
            const float inv = 1.f / l;
            f32x16 o[2];
#pragma unroll
            for (int dt = 0; dt < 2; ++dt)
#pragma unroll
                for (int r = 0; r < 16; ++r) o[dt][r] = 0.f;
            const bf16_t* vpa = VTb + (size_t)(h * 64 + r32) * 256 + 4 * hh; const bf16_t* vpb = vpa + 32 * 256;
            asm volatile("" : "+v"(vpa), "+v"(vpb));
#pragma unroll
            for (int kt = 0; kt < 8; ++kt) {
                u32x2 vl[2][2], vh[2][2];
#pragma unroll
                for (int s2 = 0; s2 < 2; ++s2)
#pragma unroll
                    for (int dt = 0; dt < 2; ++dt) { const bf16_t* vp = (dt ? vpb : vpa) + kt * 32 + s2 * 16; vl[s2][dt] = *(const u32x2*)vp; vh[s2][dt] = *(const u32x2*)(vp + 8); }
#pragma unroll
                for (int s2 = 0; s2 < 2; ++s2) {
                    v4u pk; pk.x = cvtpk(st[kt][8 * s2 + 0] * inv, st[kt][8 * s2 + 1] * inv); pk.y = cvtpk(st[kt][8 * s2 + 2] * inv, st[kt][8 * s2 + 3] * inv);
                    pk.z = cvtpk(st[kt][8 * s2 + 4] * inv, st[kt][8 * s2 + 5] * inv); pk.w = cvtpk(st[kt][8 * s2 + 6] * inv, st[kt][8 * s2 + 7] * inv);
                    const bf16x8 pa = __builtin_bit_cast(bf16x8, pk);
#pragma unroll
                    for (int dt = 0; dt < 2; ++dt) { v4u vv; vv.x = vl[s2][dt].x; vv.y = vl[s2][dt].y; vv.z = vh[s2][dt].x; vv.w = vh[s2][dt].y;
                        o[dt] = MFMA32(pa, __builtin_bit_cast(bf16x8, vv), o[dt]); }
                }
                asm volatile("" ::: "memory");
            }
#pragma unroll
            for (int dt = 0; dt < 2; ++dt) out_tile(lds, o[dt], tb * 32, h * 64 + dt * 32 + r32, hh);
        }
        WG_BAR();
        epi_pass<0>(lds, proj, H, m0, 1024, nullptr, tid);
        WG_BAR();
    }
#endif
}

DI void ln_rows(const float* Z, bf16_t* xb, float* out, const float* g, const float* b, int gw, int NGW, int lane) {
    f32x4 gg[4], bb[4];
#pragma unroll
    for (int j = 0; j < 4; ++j) { gg[j] = *(const f32x4*)(g + 4 * lane + 256 * j); bb[j] = *(const f32x4*)(b + 4 * lane + 256 * j); }
    for (int m = gw; m < M; m += NGW) {
        const f32x4* zr = (const f32x4*)(Z + (size_t)m * D_MODEL) + lane;
        f32x4 v[4]; float s = 0.f;
#pragma unroll
        for (int j = 0; j < 4; ++j) { v[j] = zr[64 * j]; s += (v[j].x + v[j].y) + (v[j].z + v[j].w); }
        const float mean = wave_sum(s) * (1.f / D_MODEL); float q = 0.f;
#pragma unroll
        for (int j = 0; j < 4; ++j) { v[j] = v[j] - mean; q += (v[j].x * v[j].x + v[j].y * v[j].y) + (v[j].z * v[j].z + v[j].w * v[j].w); }
        const float rstd = rsqrtf(wave_sum(q) * (1.f / D_MODEL) + LN_EPS);
#pragma unroll
        for (int j = 0; j < 4; ++j) { const f32x4 y = v[j] * rstd * gg[j] + bb[j];
            if (xb) { u32x2 o; o.x = cvtpk(y.x, y.y); o.y = cvtpk(y.z, y.w); ((u32x2*)(xb + (size_t)m * D_MODEL) + lane)[64 * j] = o; }
            else ((f32x4*)(out + (size_t)m * D_MODEL) + lane)[64 * j] = y; }
    }
}

template <int L_>
DI void layer_body(const Ptrs& P, LAS unsigned char* lds, const XcdBarrier& bar, gu32* ctl, int li, int lo, int hi, int tid, int lane, int wave, int G, int bx, int vcu) {
#define IN(k) (lo <= (k) && (k) < hi)
#define SEAM(k) do { if (IN(k) && IN((k) + 1)) xcd_barrier(bar); } while (0)
    unsigned char* ws = P.ws;
    bf16_t* XB = (bf16_t*)(ws + WS_XB); bf16_t* PROJ = (bf16_t*)(ws + WS_PROJ); float* Z = (float*)(ws + WS_PROJ); bf16_t* H = (bf16_t*)(ws + WS_H);
        constexpr int l = L_; const int pb = 1 + 4 * l;
        if (IN(pb)) {
            { pg8::Gemm g{XB, (const bf16_t*)(ws + WS_WIN) + (size_t)l * D_IN * D_MODEL, M, D_IN, D_MODEL}; pg8::StaticOrder S; S.init(M, D_IN, G, bx);
              pg8::EpiBf16<0> E{PROJ, D_IN, nullptr, 0, 0, 1.f};
              pg8::gemm_phase<pg8::EpiBf16<0>, pg8::StaticOrder, PG8_ALIGN, PG8_SP2>(lds + RING_OFF, g, S, E); }
            if (l == 0) {
#pragma unroll 1
                for (int l2 = 0; l2 < DEPTH; ++l2) {
                    pg8::Gemm g{(const bf16_t*)(ws + WS_MEMB), (const bf16_t*)(ws + WS_WKV) + (size_t)l2 * 512 * D_MODEL, MM, 512, D_MODEL}; pg8::StaticOrder S; S.init(MM, 512, G, (bx + G - 16 * l2 - 32) % G);
                    pg8::EpiKV E{(bf16_t*)(ws + WS_KB) + (size_t)l2 * MM * 256, (bf16_t*)(ws + WS_VT) + (size_t)l2 * MM * 256};
                    pg8::gemm_phase<pg8::EpiKV, pg8::StaticOrder, false, PG8_SP2>(lds + RING_OFF, g, S, E); }
            }
        }
        SEAM(pb);
        if (IN(pb + 1)) {
            LayerW W;
            W.conv_a_w = P.in[3] + (size_t)l * 3 * D_G; W.sg_ln_g = P.in[4] + (size_t)l * D_G; W.sg_ln_b = P.in[5] + (size_t)l * D_G;
            W.sg_w = P.in[6] + (size_t)l * 4 * 128 * 128; W.sg_b = P.in[7] + (size_t)l * 4 * 128; W.pool_w = P.in[8] + (size_t)l * 4 * 64 * 64;
            W.pool_scale = P.in[9] + (size_t)l * D_G; W.cc_dw_w = P.in[10] + (size_t)l * 31 * D_G; W.cc_dw_b = P.in[11] + (size_t)l * D_G;
            W.cc_ln_g = P.in[12] + (size_t)l * D_G; W.cc_ln_b = P.in[13] + (size_t)l * D_G; W.cc_pw_w = P.in[14] + (size_t)l * D_G * D_G;
            W.ln_g = P.in[17] + (size_t)l * D_MODEL; W.ln_b = P.in[18] + (size_t)l * D_MODEL;
            W.KB = (const bf16_t*)(ws + WS_KB) + (size_t)l * MM * 256; W.VT = (const bf16_t*)(ws + WS_VT) + (size_t)l * MM * 256;
            W.PWT = (const bf16_t*)(ws + WS_PWT) + (size_t)l * D_G * D_G; W.POOLT = (const bf16_t*)(ws + WS_POOLT) + (size_t)l * 4 * 64 * 64; W.SGW = (const bf16_t*)(ws + WS_SGW) + (size_t)l * 4 * 128 * 128;
            for (int tile = vcu; tile < NTILES; tile += G) {
                int tz = tid, wz = wave; asm volatile("" : "+v"(tz), "+s"(wz));
                mixer_tile(P, W, lds, tile, tz, wz, tz & 63); } }
        SEAM(pb + 1);
        if (IN(pb + 2)) {
            pg8::Gemm g{H, (const bf16_t*)(ws + WS_WOUT) + (size_t)l * D_MODEL * D_MIX, M, D_MODEL, D_MIX}; pg8::StaticOrder S; S.init(M, D_MODEL, G, bx);
            pg8::EpiZ E{Z, l == 0 ? P.in[0] : nullptr, XB, ALPHA};
            pg8::gemm_phase<pg8::EpiZ, pg8::StaticOrder, PG8_ALIGN, PG8_SP2>(lds + RING_OFF, g, S, E);
        }
        SEAM(pb + 2);
        if (IN(pb + 3)) {
            const bool last = (l + 1 == DEPTH);
            ln_rows(Z, last ? nullptr : XB, P.out, P.in[17] + (size_t)l * D_MODEL, P.in[18] + (size_t)l * D_MODEL, vcu * NWAVES + wave, G * NWAVES, lane);
            if (last) {
                if (xb_ld((unsigned*)(ctl + CW_BAR) + li * XCD_BAR_WORDS + XB_TMO) != 0u && tid == 0) P.out[bx] = __builtin_nanf(""); }
        }
        SEAM(pb + 3);
#undef IN
#undef SEAM
}

constexpr int N_PHASES = 9;
struct Args { Ptrs p; int ph_lo, ph_hi, li, pad; };
__global__ void __launch_bounds__(NWAVES * 64, 2) mk_fwd(Args args) {
    extern __shared__ __attribute__((aligned(16))) unsigned char lds_raw[];
    LAS unsigned char* lds = (LAS unsigned char*)lds_raw;
    volatile LAS unsigned* MISC = (volatile LAS unsigned*)(lds + MISC_OFF);
    const int tid = threadIdx.x, lane = tid & 63, wave = __builtin_amdgcn_readfirstlane(tid >> 6);
    const int G = gridDim.x; const int bx = blockIdx.x; const int vcu = (G % 8 == 0) ? (bx % 8) * (G / 8) + bx / 8 : bx;
    const Ptrs& P = args.p; unsigned char* ws = P.ws;
    for (int u = tid; u < (LDS_BYTES - MISC_OFF) / 4; u += NWAVES * 64) ((LAS unsigned*)(lds + MISC_OFF))[u] = 0u;
    __syncthreads();
    gu32* ctl = (gu32*)(ws + WS_CTL);
    XcdBarrier bar = xcd_barrier_post((unsigned*)(ctl + CW_BAR) + args.li * XCD_BAR_WORDS, MISC + 8);
    const int lo = args.ph_lo, hi = args.ph_hi;
#define IN(k) (lo <= (k) && (k) < hi)
#define SEAM(k) do { if (IN(k) && IN((k) + 1)) xcd_barrier(bar); } while (0)
    bf16_t* XB = (bf16_t*)(ws + WS_XB); bf16_t* PROJ = (bf16_t*)(ws + WS_PROJ); float* Z = (float*)(ws + WS_PROJ); bf16_t* H = (bf16_t*)(ws + WS_H);

    if (IN(0)) { p0_prologue(P, lds, vcu, G, wave, lane); }
    SEAM(0);
    layer_body<0>(P, lds, bar, ctl, args.li, lo, hi, tid, lane, wave, G, bx, vcu);
    layer_body<1>(P, lds, bar, ctl, args.li, lo, hi, tid, lane, wave, G, bx, vcu);
#undef IN
#undef SEAM
}

#ifndef NAIVE_MASK
#define NAIVE_MASK 0
#endif
#if NAIVE_MASK
#define PJ(m, c) bf2f(proj[(size_t)(m) * D_IN + (c)])
#define GRID_STRIDE(i, n) for (size_t i = (size_t)blockIdx.x * blockDim.x + threadIdx.x; i < (size_t)(n); i += (size_t)gridDim.x * blockDim.x)
__device__ __forceinline__ float n_sig(float x) { return 1.f / (1.f + __expf(-x)); }
__device__ __forceinline__ float n_silu(float x) { return x * n_sig(x); }
__device__ __forceinline__ float n_gelu(float x) { const float u = 0.7978845608028654f * (x + 0.044715f * x * x * x); return x * n_sig(2.f * u); }
__global__ void k_cvt(const float* __restrict__ src, bf16_t* __restrict__ dst, size_t n) { GRID_STRIDE(i, n) dst[i] = (bf16_t)f2bf(src[i]); }
__global__ void k_cvt_t(const float* __restrict__ W, bf16_t* __restrict__ WT, int K, int N) { GRID_STRIDE(i, (size_t)K * N) { const int n = (int)(i / K), k = (int)(i % K); WT[i] = (bf16_t)f2bf(W[(size_t)k * N + n]); } }
__global__ void k_cvt_sgw(const float* __restrict__ W, bf16_t* __restrict__ O) { GRID_STRIDE(i, (size_t)DEPTH * 4 * 128 * 128) { const int s = (int)(i & 127), t = (int)((i >> 7) & 127); O[i] = (bf16_t)f2bf(s <= t ? W[i] : 0.f); } }
struct NEpiBf16 { bf16_t* C; int ldc; __device__ void operator()(int r, int c, float v) const { C[(size_t)r * ldc + c] = (bf16_t)f2bf(v); } };
struct NEpiKV { bf16_t* KB; bf16_t* VT; __device__ void operator()(int r, int c, float v) const { if (c < 256) KB[(size_t)r * 256 + c] = (bf16_t)f2bf(v); else VT[((size_t)((r >> 8) * 256 + c - 256)) * 256 + (r & 255)] = (bf16_t)f2bf(v); } };
struct NEpiResid { float* Z; const float* xf; const bf16_t* xb; __device__ void operator()(int r, int c, float v) const { const size_t o = (size_t)r * D_MODEL + c; Z[o] = ALPHA * (xf ? xf[o] : bf2f(xb[o])) + v; } };
template <class Epi>
__global__ void __launch_bounds__(256) k_gemm_simple(const bf16_t* __restrict__ A, const bf16_t* __restrict__ Bt, int Mr, int N, int K, Epi epi) {
    __shared__ float sA[16][65], sB[16][65];
    const int bm = blockIdx.y * 64, bn = blockIdx.x * 64, tid = threadIdx.x, tx = tid & 15, ty = tid >> 4;
    float acc[4][4];
#pragma unroll
    for (int i = 0; i < 4; ++i)
#pragma unroll
        for (int j = 0; j < 4; ++j) acc[i][j] = 0.f;
    for (int k0 = 0; k0 < K; k0 += 16) {
#pragma unroll
        for (int i = 0; i < 4; ++i) { const int e = tid + i * 256, r = e >> 4, c = e & 15; sA[c][r] = bf2f(A[(size_t)(bm + r) * K + k0 + c]); sB[c][r] = bf2f(Bt[(size_t)(bn + r) * K + k0 + c]); }
        __syncthreads();
#pragma unroll
        for (int kk = 0; kk < 16; ++kk) { float a[4], b[4];
#pragma unroll
            for (int i = 0; i < 4; ++i) { a[i] = sA[kk][ty * 4 + i]; b[i] = sB[kk][tx * 4 + i]; }
#pragma unroll
            for (int i = 0; i < 4; ++i)
#pragma unroll
                for (int j = 0; j < 4; ++j) acc[i][j] += a[i] * b[j]; }
        __syncthreads();
    }
#pragma unroll
    for (int i = 0; i < 4; ++i)
#pragma unroll
        for (int j = 0; j < 4; ++j) epi(bm + ty * 4 + i, bn + tx * 4 + j, acc[i][j]);
}
__global__ void k_branch_a(const bf16_t* __restrict__ proj, bf16_t* __restrict__ H, LayerW w) {
    GRID_STRIDE(i, (size_t)M * D_G) { const int m = (int)(i / D_G), c = (int)(i % D_G), t = m % SEQ;
        const float p0 = PJ(m, C_CA + c) * PJ(m, C_XA + c), p1 = t >= 1 ? PJ(m - 1, C_CA + c) * PJ(m - 1, C_XA + c) : 0.f, p2 = t >= 2 ? PJ(m - 2, C_CA + c) * PJ(m - 2, C_XA + c) : 0.f;
        const float cv = w.conv_a_w[c] * p2 + w.conv_a_w[D_G + c] * p1 + w.conv_a_w[2 * D_G + c] * p0;
        H[(size_t)m * D_MIX + c] = (bf16_t)f2bf(PJ(m, C_BA + c) * cv * n_silu(PJ(m, C_GATE + c))); }
}
__global__ void __launch_bounds__(256) k_row_ln256(const bf16_t* __restrict__ proj, const float* __restrict__ Tin, float* __restrict__ Tout, const float* __restrict__ g, const float* __restrict__ b, int mode) {
    const int lane = threadIdx.x & 63; const int row0 = blockIdx.x * 4 + (threadIdx.x >> 6);
    for (int m = row0; m < M; m += gridDim.x * 4) { float v[4]; float s = 0.f;
#pragma unroll
        for (int j = 0; j < 4; ++j) { const int c = lane + 64 * j; v[j] = mode == 0 ? n_gelu(PJ(m, C_V + c)) : Tin[(size_t)m * D_G + c]; s += v[j]; }
        const float mean = wave_sum(s) * (1.f / D_G); float q = 0.f;
#pragma unroll
        for (int j = 0; j < 4; ++j) { v[j] -= mean; q += v[j] * v[j]; }
        const float rstd = rsqrtf(wave_sum(q) * (1.f / D_G) + LN_EPS);
#pragma unroll
        for (int j = 0; j < 4; ++j) { const int c = lane + 64 * j; float y = v[j] * rstd * g[c] + b[c]; if (mode == 1) y = n_silu(y); Tout[(size_t)m * D_G + c] = y; } }
}
__global__ void k_branch_b2(const bf16_t* __restrict__ proj, const float* __restrict__ T, bf16_t* __restrict__ H, LayerW w) {
    GRID_STRIDE(i, (size_t)M * D_G) { const int m = (int)(i / D_G), c = (int)(i % D_G), t = m % 128, mb = m - t, h = c / 64; const float* wr = w.sg_w + ((size_t)h * 128 + t) * 128; float acc = 0.f;
        for (int s = 0; s <= t; ++s) acc += wr[s] * T[(size_t)(mb + s) * D_G + c];
        acc += w.sg_b[h * 128 + t];
        H[(size_t)m * D_MIX + 256 + c] = (bf16_t)f2bf(n_gelu(PJ(m, C_U + c)) * acc * n_silu(PJ(m, C_GATE + 256 + c))); }
}
__global__ void k_branch_c1(const bf16_t* __restrict__ proj, float* __restrict__ T) {
    GRID_STRIDE(i, (size_t)M * D_G) { const int m = (int)(i / D_G), c = (int)(i % D_G), t = m % SEQ, g = c / 64, win = 2 << g; const int cnt = (t + 1) < win ? (t + 1) : win; float s = 0.f;
        for (int j = 0; j < cnt; ++j) s += PJ(m - j, C_XC + c);
        T[i] = s / (float)cnt - PJ(m, C_XC + c); }
}
__global__ void k_branch_c2(const bf16_t* __restrict__ proj, const float* __restrict__ T, bf16_t* __restrict__ H, LayerW w) {
    GRID_STRIDE(i, (size_t)M * D_G) { const int m = (int)(i / D_G), n = (int)(i % D_G), g = n / 64, d = n % 64; float acc = 0.f;
        for (int c = 0; c < 64; ++c) acc += T[(size_t)m * D_G + g * 64 + c] * w.pool_w[((size_t)g * 64 + c) * 64 + d];
        H[(size_t)m * D_MIX + 512 + n] = (bf16_t)f2bf(acc * w.pool_scale[n] * n_silu(PJ(m, C_GATE + 512 + n))); }
}
__global__ void k_branch_d1(const bf16_t* __restrict__ proj, float* __restrict__ T, LayerW w) {
    GRID_STRIDE(i, (size_t)M * D_G) { const int m = (int)(i / D_G), c = (int)(i % D_G), t = m % SEQ; float acc = w.cc_dw_b[c];
        for (int j = 0; j < 31; ++j) { const int tt = t - 30 + j; if (tt >= 0) { const int mm = m - 30 + j; acc += w.cc_dw_w[j * D_G + c] * (PJ(mm, C_DA + c) * n_sig(PJ(mm, C_DG + c))); } }
        T[i] = acc; }
}
__global__ void k_branch_d3(const bf16_t* __restrict__ proj, const float* __restrict__ T, bf16_t* __restrict__ H, LayerW w) {
    GRID_STRIDE(i, (size_t)M * D_G) { const int m = (int)(i / D_G), n = (int)(i % D_G); float acc = 0.f;
        for (int k = 0; k < D_G; ++k) acc += T[(size_t)m * D_G + k] * w.cc_pw_w[(size_t)k * D_G + n];
        H[(size_t)m * D_MIX + 768 + n] = (bf16_t)f2bf(acc * n_silu(PJ(m, C_GATE + 768 + n))); }
}
__global__ void __launch_bounds__(256) k_branch_e(const bf16_t* __restrict__ proj, const bf16_t* __restrict__ KB, const bf16_t* __restrict__ VT, bf16_t* __restrict__ H) {
    const int idx = blockIdx.x * blockDim.x + threadIdx.x; const int h = idx / M, m = idx % M, b = m / SEQ;
    if (h >= 4) return;
    float q[64], acc[64];
#pragma unroll
    for (int d = 0; d < 64; ++d) { q[d] = PJ(m, C_Q + h * 64 + d) * 0.125f; acc[d] = 0.f; }
    float mx = -1e30f, l = 0.f;
    for (int key = 0; key < MEM_LEN; ++key) { const bf16_t* kr = KB + (size_t)(b * MEM_LEN + key) * 256 + h * 64; float s = 0.f;
#pragma unroll
        for (int d = 0; d < 64; ++d) s += q[d] * bf2f(kr[d]);
        const float mn = fmaxf(mx, s), a = __expf(mx - mn), p = __expf(s - mn); l = l * a + p; mx = mn;
#pragma unroll
        for (int d = 0; d < 64; ++d) acc[d] = acc[d] * a + p * bf2f(VT[((size_t)(b * 256 + h * 64 + d)) * 256 + key]); }
    const float inv = 1.f / l;
#pragma unroll
    for (int d = 0; d < 64; ++d) H[(size_t)m * D_MIX + 1024 + h * 64 + d] = (bf16_t)f2bf(acc[d] * inv * n_silu(PJ(m, C_GATE + 1024 + h * 64 + d)));
}
__global__ void __launch_bounds__(256) k_ln1024(const float* __restrict__ Z, bf16_t* __restrict__ xb, float* __restrict__ out, const float* __restrict__ g, const float* __restrict__ b) {
    const int lane = threadIdx.x & 63; const int row0 = blockIdx.x * 4 + (threadIdx.x >> 6);
    for (int m = row0; m < M; m += gridDim.x * 4) { float v[16]; float s = 0.f;
#pragma unroll
        for (int j = 0; j < 16; ++j) { v[j] = Z[(size_t)m * D_MODEL + lane + 64 * j]; s += v[j]; }
        const float mean = wave_sum(s) * (1.f / D_MODEL); float q = 0.f;
#pragma unroll
        for (int j = 0; j < 16; ++j) { v[j] -= mean; q += v[j] * v[j]; }
        const float rstd = rsqrtf(wave_sum(q) * (1.f / D_MODEL) + LN_EPS);
#pragma unroll
        for (int j = 0; j < 16; ++j) { const int c = lane + 64 * j; const float y = v[j] * rstd * g[c] + b[c]; if (xb) xb[(size_t)m * D_MODEL + c] = (bf16_t)f2bf(y); else out[(size_t)m * D_MODEL + c] = y; } }
}
static void naive_phase(int ph, void* const* d_in, float* out, unsigned char* ws, hipStream_t stream) {
    const int G = 2048, B = 256;
    bf16_t* XB = (bf16_t*)(ws + WS_XB); bf16_t* PROJ = (bf16_t*)(ws + WS_PROJ); float* Z = (float*)(ws + WS_PROJ); bf16_t* H = (bf16_t*)(ws + WS_H);
    float* T1 = (float*)(ws + WS_T1); float* T2 = (float*)(ws + WS_T2);
    if (ph == 0) {
        k_cvt<<<G, B, 0, stream>>>((const float*)d_in[0], XB, (size_t)M * D_MODEL);
        k_cvt<<<G, B, 0, stream>>>((const float*)d_in[1], (bf16_t*)(ws + WS_MEMB), (size_t)MM * D_MODEL);
        k_cvt_sgw<<<G, B, 0, stream>>>((const float*)d_in[6], (bf16_t*)(ws + WS_SGW));
        for (int l = 0; l < DEPTH; ++l) {
            k_cvt_t<<<G, B, 0, stream>>>((const float*)d_in[2] + (size_t)l * D_MODEL * D_IN, (bf16_t*)(ws + WS_WIN) + (size_t)l * D_IN * D_MODEL, D_MODEL, D_IN);
            k_cvt_t<<<G, B, 0, stream>>>((const float*)d_in[16] + (size_t)l * D_MIX * D_MODEL, (bf16_t*)(ws + WS_WOUT) + (size_t)l * D_MODEL * D_MIX, D_MIX, D_MODEL);
            k_cvt_t<<<G, B, 0, stream>>>((const float*)d_in[15] + (size_t)l * D_MODEL * 512, (bf16_t*)(ws + WS_WKV) + (size_t)l * 512 * D_MODEL, D_MODEL, 512);
            k_cvt_t<<<G, B, 0, stream>>>((const float*)d_in[14] + (size_t)l * D_G * D_G, (bf16_t*)(ws + WS_PWT) + (size_t)l * D_G * D_G, D_G, D_G);
            for (int g = 0; g < 4; ++g) k_cvt_t<<<16, B, 0, stream>>>((const float*)d_in[8] + ((size_t)l * 4 + g) * 4096, (bf16_t*)(ws + WS_POOLT) + ((size_t)l * 4 + g) * 4096, 64, 64);
        }
        return;
    }
    const int l = (ph - 1) / 4, sub = (ph - 1) % 4;
    LayerW w;
    w.conv_a_w = (const float*)d_in[3] + (size_t)l * 3 * D_G; w.sg_ln_g = (const float*)d_in[4] + (size_t)l * D_G; w.sg_ln_b = (const float*)d_in[5] + (size_t)l * D_G;
    w.sg_w = (const float*)d_in[6] + (size_t)l * 4 * 128 * 128; w.sg_b = (const float*)d_in[7] + (size_t)l * 4 * 128; w.pool_w = (const float*)d_in[8] + (size_t)l * 4 * 64 * 64;
    w.pool_scale = (const float*)d_in[9] + (size_t)l * D_G; w.cc_dw_w = (const float*)d_in[10] + (size_t)l * 31 * D_G; w.cc_dw_b = (const float*)d_in[11] + (size_t)l * D_G;
    w.cc_ln_g = (const float*)d_in[12] + (size_t)l * D_G; w.cc_ln_b = (const float*)d_in[13] + (size_t)l * D_G; w.cc_pw_w = (const float*)d_in[14] + (size_t)l * D_G * D_G;
    w.ln_g = (const float*)d_in[17] + (size_t)l * D_MODEL; w.ln_b = (const float*)d_in[18] + (size_t)l * D_MODEL;
    w.KB = (const bf16_t*)(ws + WS_KB) + (size_t)l * MM * 256; w.VT = (const bf16_t*)(ws + WS_VT) + (size_t)l * MM * 256; w.PWT = nullptr; w.POOLT = nullptr; w.SGW = nullptr;
    if (sub == 0) {
        k_gemm_simple<<<dim3(D_IN / 64, M / 64), 256, 0, stream>>>(XB, (const bf16_t*)(ws + WS_WIN) + (size_t)l * D_IN * D_MODEL, M, D_IN, D_MODEL, NEpiBf16{PROJ, D_IN});
        if (l == 0) for (int l2 = 0; l2 < DEPTH; ++l2)
            k_gemm_simple<<<dim3(512 / 64, MM / 64), 256, 0, stream>>>((const bf16_t*)(ws + WS_MEMB), (const bf16_t*)(ws + WS_WKV) + (size_t)l2 * 512 * D_MODEL, MM, 512, D_MODEL, NEpiKV{(bf16_t*)(ws + WS_KB) + (size_t)l2 * MM * 256, (bf16_t*)(ws + WS_VT) + (size_t)l2 * MM * 256});
    } else if (sub == 1) {
        k_branch_a<<<G * 2, B, 0, stream>>>(PROJ, H, w);
        k_row_ln256<<<G, B, 0, stream>>>(PROJ, nullptr, T1, w.sg_ln_g, w.sg_ln_b, 0);
        k_branch_b2<<<G * 2, B, 0, stream>>>(PROJ, T1, H, w);
        k_branch_c1<<<G * 2, B, 0, stream>>>(PROJ, T1);
        k_branch_c2<<<G * 2, B, 0, stream>>>(PROJ, T1, H, w);
        k_branch_d1<<<G * 2, B, 0, stream>>>(PROJ, T1, w);
        k_row_ln256<<<G, B, 0, stream>>>(PROJ, T1, T2, w.cc_ln_g, w.cc_ln_b, 1);
        k_branch_d3<<<G * 2, B, 0, stream>>>(PROJ, T2, H, w);
        k_branch_e<<<(4 * M) / 256, 256, 0, stream>>>(PROJ, w.KB, w.VT, H);
    } else if (sub == 2) {
        k_gemm_simple<<<dim3(D_MODEL / 64, M / 64), 256, 0, stream>>>(H, (const bf16_t*)(ws + WS_WOUT) + (size_t)l * D_MODEL * D_MIX, M, D_MODEL, D_MIX, NEpiResid{Z, l == 0 ? (const float*)d_in[0] : nullptr, XB});
    } else {
        k_ln1024<<<G, B, 0, stream>>>(Z, l + 1 < DEPTH ? XB : nullptr, out, w.ln_g, w.ln_b);
    }
}
#endif

extern "C" void kernel_launch(void* const* d_in, const int* in_sizes, int n_in, void* d_out, int out_size, void* d_ws, size_t ws_size, hipStream_t stream) {
    static int grid = 0;
    if (grid == 0) {
        if (n_in != 19 || in_sizes[0] != M * D_MODEL || out_size != M * D_MODEL || ws_size < WS_END) { fprintf(stderr, "kernel_launch: built for 19 inputs, x/out of %d floats, >= %zu bytes of workspace; got n_in %d, out %d, ws %zu; nothing launched\n", M * D_MODEL, (size_t)WS_END, n_in, out_size, ws_size); grid = -1; return; }
        int dev = 0, cus = 0, per_cu = 0;
        if (hipGetDevice(&dev) != hipSuccess || hipDeviceGetAttribute(&cus, hipDeviceAttributeMultiprocessorCount, dev) != hipSuccess) { fprintf(stderr, "kernel_launch: device query failed\n"); grid = -1; return; }
        if (hipFuncSetAttribute((const void*)mk_fwd, hipFuncAttributeMaxDynamicSharedMemorySize, LDS_BYTES) != hipSuccess) { fprintf(stderr, "kernel_launch: hipFuncSetAttribute(%d B LDS) failed\n", LDS_BYTES); grid = -1; return; }
        if (hipOccupancyMaxActiveBlocksPerMultiprocessor(&per_cu, (const void*)mk_fwd, NWAVES * 64, LDS_BYTES) != hipSuccess || per_cu < 1) { fprintf(stderr, "kernel_launch: occupancy query reports %d workgroups per CU\n", per_cu); per_cu = 1; }
        (void)hipGetLastError();
        grid = cus;
        if (per_cu != 1) fprintf(stderr, "kernel_launch: note: occupancy query says %d per CU; launching one per CU\n", per_cu);
    }
    if (grid < 0) return;
    if (hipMemsetAsync((char*)d_ws + WS_CTL, 0, CTL_ZERO_BYTES, stream) != hipSuccess) { fprintf(stderr, "kernel_launch: hipMemsetAsync failed\n"); return; }
    Args a{};
    for (int i = 0; i < 19; ++i) a.p.in[i] = (const float*)d_in[i];
    a.p.out = (float*)d_out; a.p.ws = (unsigned char*)d_ws;
    int li = 0;
    for (int ph = 0; ph < N_PHASES;) {
#if NAIVE_MASK
        if ((NAIVE_MASK >> ph) & 1) { naive_phase(ph, d_in, (float*)d_out, (unsigned char*)d_ws, stream); ++ph; continue; }
#endif
        int hi = ph + 1;
#ifndef ONE_LAUNCH_PER_PHASE
        while (hi < N_PHASES && !((NAIVE_MASK >> hi) & 1)) ++hi;
#endif
        a.ph_lo = ph; a.ph_hi = hi; a.li = li++;
        hipLaunchKernelGGL(mk_fwd, dim3(grid), dim3(NWAVES * 64), LDS_BYTES, stream, a);
        const hipError_t le = hipPeekAtLastError();
        if (le != hipSuccess) { fprintf(stderr, "kernel_launch: launch failed: %s (grid %d x %d threads, %d B LDS)\n", hipGetErrorName(le), grid, NWAVES * 64, LDS_BYTES); break; }
        ph = hi;
    }
}
```
